# Optimizing an MI355X kernel written in HIP

```python
import math
import jax, jax.numpy as jnp
from jax import lax
import numpy as np

D_MODEL = 1024
BATCH = 16
SEQ = 2048
DEPTH = 1
DEC_BATCH = 128
DEC_SEQ = 4
PAST_LEN = 16384
PAGE_SIZE = 128

ATTN_WIDTH = D_MODEL // 2
SSM_WIDTH = D_MODEL - ATTN_WIDTH
HEAD_DIM = 64
N_HEADS = ATTN_WIDTH // HEAD_DIM
N_KV_HEADS = 2
GQA_GROUP = N_HEADS // N_KV_HEADS
KV_WIDTH = N_KV_HEADS * HEAD_DIM
WINDOW = 128
BLOCK = WINDOW
ROT_DIM = HEAD_DIM // 4
ROPE_THETA = 500000.0
SSM_GROUP = 16
N_SSM_GROUPS = SSM_WIDTH // SSM_GROUP
SSM_STATE = 64
DT_MIN = 1e-3
DT_MAX = 1e-1
D_FF = 4 * D_MODEL
IN_WIDTH = ATTN_WIDTH + 2 * KV_WIDTH + SSM_WIDTH
NORM_EPS = 1e-6
NEG_INF = -1e30

kernel_name = "hymba_swa_sink_s5_sqrelu_step"


def _rmsnorm(x, g):
    xf = x.astype(jnp.float32)
    y = xf * lax.rsqrt(jnp.mean(xf * xf, axis=-1, keepdims=True) + NORM_EPS)
    return (y * g.astype(jnp.float32)).astype(x.dtype)


def _rotary(x, pos):
    half = ROT_DIM // 2
    inv_freq = jnp.power(ROPE_THETA, -jnp.arange(half, dtype=jnp.float32) * (2.0 / ROT_DIM))
    ang = pos.astype(jnp.float32)[:, None] * inv_freq[None, :]
    cos = jnp.cos(ang)[:, None, :]
    sin = jnp.sin(ang)[:, None, :]
    xr = x[..., :ROT_DIM].astype(jnp.float32)
    x1, x2 = xr[..., :half], xr[..., half:]
    rot = jnp.concatenate([x1 * cos - x2 * sin, x2 * cos + x1 * sin], axis=-1).astype(x.dtype)
    return jnp.concatenate([rot, x[..., ROT_DIM:]], axis=-1)


def _sink_attention(q, k, v, mask, sinks):
    s = jnp.einsum('...qkgd,...skd->...kgqs', q, k,
                   preferred_element_type=jnp.float32) * (HEAD_DIM ** -0.5)
    s = jnp.where(mask, s, NEG_INF)
    sink = sinks.astype(jnp.float32).reshape(N_KV_HEADS, GQA_GROUP, 1, 1)
    m = jnp.maximum(jnp.max(s, axis=-1, keepdims=True), sink)
    p = jnp.exp(s - m)
    denom = jnp.sum(p, axis=-1, keepdims=True) + jnp.exp(sink - m)
    return jnp.einsum('...kgqs,...skd->...qkgd', (p / denom).astype(v.dtype), v)


def _banded_attention(q, k, v, sinks):
    B_, L = q.shape[0], q.shape[1]
    nb = L // BLOCK
    qb = q.reshape(B_, nb, BLOCK, N_KV_HEADS, GQA_GROUP, HEAD_DIM)

    def with_prev(t):
        tb = t.reshape(B_, nb, BLOCK, N_KV_HEADS, HEAD_DIM)
        prev = jnp.concatenate([jnp.zeros_like(tb[:, :1]), tb[:, :-1]], axis=1)
        return jnp.concatenate([prev, tb], axis=2)

    kk, vv = with_prev(k), with_prev(v)
    i = jnp.arange(BLOCK)[:, None]
    j = jnp.arange(2 * BLOCK)[None, :]
    diff = i + BLOCK - j
    band = (diff >= 0) & (diff < WINDOW)
    kpos = jnp.arange(nb)[:, None, None] * BLOCK - BLOCK + j[None]
    mask = (band[None] & (kpos >= 0))[None, :, None, None]
    o = _sink_attention(qb, kk, vv, mask, sinks)
    return o.reshape(B_, L, ATTN_WIDTH)


def _window_step_attention(q, k_new, v_new, cache_k, cache_v, sinks):
    Bd, S = q.shape[0], q.shape[1]
    W = cache_k.shape[1]
    kk = jnp.concatenate([cache_k.astype(k_new.dtype), k_new], axis=1)
    vv = jnp.concatenate([cache_v.astype(v_new.dtype), v_new], axis=1)
    i = jnp.arange(S)[:, None]
    j = jnp.arange(W + S)[None, :]
    diff = i + W - j
    mask = ((diff >= 0) & (diff < WINDOW))[None, None, None]
    qg = q.reshape(Bd, S, N_KV_HEADS, GQA_GROUP, HEAD_DIM)
    o = _sink_attention(qg, kk, vv, mask, sinks)
    return o.reshape(Bd, S, ATTN_WIDTH), kk[:, -W:], vv[:, -W:]


def _ssm_mixer(u, s0_re, s0_im, a_re, a_im, log_dt, b_re, b_im, c_re, c_im, d_skip, w_glu, b_glu):
    f32 = jnp.float32
    B_, L = u.shape[0], u.shape[1]
    ar, ai = a_re.astype(f32), a_im.astype(f32)
    dt = jnp.exp(log_dt.astype(f32))[:, None]
    mag = jnp.exp(ar * dt)
    ab_re, ab_im = mag * jnp.cos(ai * dt), mag * jnp.sin(ai * dt)
    den = ar * ar + ai * ai
    nr, ni = ab_re - 1.0, ab_im
    f_re = (nr * ar + ni * ai) / den
    f_im = (ni * ar - nr * ai) / den
    br, bi = b_re.astype(f32), b_im.astype(f32)
    bb_re = f_re[..., None] * br - f_im[..., None] * bi
    bb_im = f_re[..., None] * bi + f_im[..., None] * br

    uf = u.astype(f32).reshape(B_, L, N_SSM_GROUPS, SSM_GROUP)
    bu_re = jnp.einsum('blgc,gpc->blgp', uf, bb_re)
    bu_im = jnp.einsum('blgc,gpc->blgp', uf, bb_im)
    shape_a = (1, L, N_SSM_GROUPS, SSM_STATE)
    a_seq_re = jnp.broadcast_to(ab_re[None, None], shape_a)
    a_seq_im = jnp.broadcast_to(ab_im[None, None], shape_a)

    def combine(e1, e2):
        a1r, a1i, b1r, b1i = e1
        a2r, a2i, b2r, b2i = e2
        return (a1r * a2r - a1i * a2i,
                a1r * a2i + a1i * a2r,
                a2r * b1r - a2i * b1i + b2r,
                a2r * b1i + a2i * b1r + b2i)

    acr, aci, xr, xi = lax.associative_scan(combine, (a_seq_re, a_seq_im, bu_re, bu_im), axis=1)
    if s0_re is not None:
        s0r = s0_re.astype(f32)[:, None]
        s0i = s0_im.astype(f32)[:, None]
        xr, xi = xr + acr * s0r - aci * s0i, xi + acr * s0i + aci * s0r
    y = (jnp.einsum('blgp,gcp->blgc', xr, c_re.astype(f32))
         - jnp.einsum('blgp,gcp->blgc', xi, c_im.astype(f32)))
    y = y.reshape(B_, L, SSM_WIDTH) + d_skip.astype(f32) * u.astype(f32)
    g = jax.nn.gelu(y)
    g = g * jax.nn.sigmoid(g @ w_glu.astype(f32) + b_glu.astype(f32))
    return g.astype(u.dtype), xr[:, -1], xi[:, -1]


def _layer(x, pos, cache_k, cache_v, s0_re, s0_im,
           g_mix_pre, w_in, sinks, a_re, a_im, log_dt, b_re, b_im, c_re, c_im, d_skip,
           w_glu, b_glu, w_out, g_mix_post, g_mlp_pre, w_up, w_down, g_mlp_post):
    B_, L = x.shape[0], x.shape[1]
    h = _rmsnorm(x, g_mix_pre)
    proj = h @ w_in
    q, k, v, u = jnp.split(proj, [ATTN_WIDTH, ATTN_WIDTH + KV_WIDTH, ATTN_WIDTH + 2 * KV_WIDTH], axis=-1)
    q = _rotary(q.reshape(B_, L, N_HEADS, HEAD_DIM), pos)
    k = _rotary(k.reshape(B_, L, N_KV_HEADS, HEAD_DIM), pos)
    v = v.reshape(B_, L, N_KV_HEADS, HEAD_DIM)
    if cache_k is None:
        att = _banded_attention(q, k, v, sinks)
        keep = min(WINDOW, L)
        k_state, v_state = k[:, -keep:], v[:, -keep:]
    else:
        att, k_state, v_state = _window_step_attention(q, k, v, cache_k, cache_v, sinks)
    ssm, s_re, s_im = _ssm_mixer(u, s0_re, s0_im, a_re, a_im, log_dt, b_re, b_im,
                                 c_re, c_im, d_skip, w_glu, b_glu)
    mix = jnp.concatenate([att, ssm], axis=-1) @ w_out
    x = x + _rmsnorm(mix, g_mix_post)
    h = _rmsnorm(x, g_mlp_pre)
    f = jnp.square(jax.nn.relu(h @ w_up)) @ w_down
    x = x + _rmsnorm(f, g_mlp_post)
    return x, k_state, v_state, s_re, s_im


def setup_inputs(seed: int = 0) -> dict:
    key = jax.random.key(seed)
    ks = jax.random.split(key, 32)
    f32 = jnp.float32
    win = min(WINDOW, PAST_LEN)
    nrm = lambda k, shape, scale: jax.random.normal(k, shape, f32) * scale
    n_idx = jnp.arange(SSM_STATE, dtype=f32)
    return {
        "x_prompt": nrm(ks[0], (BATCH, SEQ, D_MODEL), 1.0),
        "x_sample": nrm(ks[1], (DEC_BATCH, DEC_SEQ, D_MODEL), 1.0),
        "cache_k": nrm(ks[2], (DEPTH, DEC_BATCH, win, N_KV_HEADS, HEAD_DIM), 1.0),
        "cache_v": nrm(ks[3], (DEPTH, DEC_BATCH, win, N_KV_HEADS, HEAD_DIM), 1.0),
        "state_ssm_re": nrm(ks[4], (DEPTH, DEC_BATCH, N_SSM_GROUPS, SSM_STATE), 0.1),
        "state_ssm_im": nrm(ks[5], (DEPTH, DEC_BATCH, N_SSM_GROUPS, SSM_STATE), 0.1),
        "g_mix_pre": 1.0 + nrm(ks[6], (DEPTH, D_MODEL), 0.01),
        "w_in": nrm(ks[7], (DEPTH, D_MODEL, IN_WIDTH), D_MODEL ** -0.5),
        "sinks": nrm(ks[8], (DEPTH, N_HEADS), 0.5),
        "a_re": -0.5 + nrm(ks[9], (DEPTH, N_SSM_GROUPS, SSM_STATE), 0.01),
        "a_im": math.pi * n_idx[None, None, :] + nrm(ks[10], (DEPTH, N_SSM_GROUPS, SSM_STATE), 0.01),
        "log_dt": jax.random.uniform(ks[11], (DEPTH, N_SSM_GROUPS), f32,
                                     math.log(DT_MIN), math.log(DT_MAX)),
        "b_re": nrm(ks[12], (DEPTH, N_SSM_GROUPS, SSM_STATE, SSM_GROUP), (2 * SSM_GROUP) ** -0.5),
        "b_im": nrm(ks[13], (DEPTH, N_SSM_GROUPS, SSM_STATE, SSM_GROUP), (2 * SSM_GROUP) ** -0.5),
        "c_re": nrm(ks[14], (DEPTH, N_SSM_GROUPS, SSM_GROUP, SSM_STATE), (2 * SSM_STATE) ** -0.5),
        "c_im": nrm(ks[15], (DEPTH, N_SSM_GROUPS, SSM_GROUP, SSM_STATE), (2 * SSM_STATE) ** -0.5),
        "d_skip": nrm(ks[16], (DEPTH, SSM_WIDTH), 1.0),
        "w_glu": nrm(ks[17], (DEPTH, SSM_WIDTH, SSM_WIDTH), SSM_WIDTH ** -0.5),
        "b_glu": nrm(ks[18], (DEPTH, SSM_WIDTH), 0.01),
        "w_out": nrm(ks[19], (DEPTH, D_MODEL, D_MODEL), D_MODEL ** -0.5),
        "g_mix_post": 1.0 + nrm(ks[20], (DEPTH, D_MODEL), 0.01),
        "g_mlp_pre": 1.0 + nrm(ks[21], (DEPTH, D_MODEL), 0.01),
        "w_up": nrm(ks[22], (DEPTH, D_MODEL, D_FF), D_MODEL ** -0.5),
        "w_down": nrm(ks[23], (DEPTH, D_FF, D_MODEL), D_FF ** -0.5),
        "g_mlp_post": 1.0 + nrm(ks[24], (DEPTH, D_MODEL), 0.01),
    }


def reference(x_prompt, x_sample, cache_k, cache_v, state_ssm_re, state_ssm_im,
              g_mix_pre, w_in, sinks, a_re, a_im, log_dt, b_re, b_im, c_re, c_im, d_skip,
              w_glu, b_glu, w_out, g_mix_post, g_mlp_pre, w_up, w_down, g_mlp_post):
    pos_prompt = jnp.arange(x_prompt.shape[1], dtype=jnp.int32)
    pos_sample = PAST_LEN + jnp.arange(x_sample.shape[1], dtype=jnp.int32)
    yp, ys = x_prompt, x_sample
    kp_l, vp_l, srp_l, sip_l = [], [], [], []
    ks_l, vs_l, srs_l, sis_l = [], [], [], []
    for l in range(DEPTH):
        w = (g_mix_pre[l], w_in[l], sinks[l], a_re[l], a_im[l], log_dt[l], b_re[l], b_im[l],
             c_re[l], c_im[l], d_skip[l], w_glu[l], b_glu[l], w_out[l], g_mix_post[l],
             g_mlp_pre[l], w_up[l], w_down[l], g_mlp_post[l])
        yp, kp, vp, srp, sip = _layer(yp, pos_prompt, None, None, None, None, *w)
        ys, kss, vss, srs, sis = _layer(ys, pos_sample, cache_k[l], cache_v[l],
                                        state_ssm_re[l], state_ssm_im[l], *w)
        kp_l.append(kp); vp_l.append(vp); srp_l.append(srp); sip_l.append(sip)
        ks_l.append(kss); vs_l.append(vss); srs_l.append(srs); sis_l.append(sis)
    k_win_prompt = jnp.stack(kp_l)
    v_win_prompt = jnp.stack(vp_l)
    ssm_re_prompt = jnp.stack(srp_l)
    ssm_im_prompt = jnp.stack(sip_l)
    k_win_sample = jnp.stack(ks_l)
    v_win_sample = jnp.stack(vs_l)
    ssm_re_sample = jnp.stack(srs_l)
    ssm_im_sample = jnp.stack(sis_l)
    return (yp, ys, k_win_prompt, v_win_prompt, ssm_re_prompt, ssm_im_prompt,
            k_win_sample, v_win_sample, ssm_re_sample, ssm_im_sample)
```

```cpp
#include <hip/hip_runtime.h>
#include <cstdio>
#include <cstdint>
namespace pg8 {
#define PG8_LAS __attribute__((address_space(3)))
typedef unsigned short bf16_t;
typedef short bf16x8 __attribute__((ext_vector_type(8)));
typedef float f32x4 __attribute__((ext_vector_type(4)));
typedef unsigned u32x4 __attribute__((ext_vector_type(4)));
constexpr int BM = 256, BK = 64, HALF = 128, HTB = HALF * BK * 2  , STAGE_BYTES = 8 * HTB, NXCD = 8, WGM = 8;

__host__ __device__ __forceinline__ int lds_byte(int r, int c) { const int st = (r >> 4) * 2 + (c >> 5), rr = r & 15, cc = c & 31, ob = rr * 64 + cc * 2; return st * 1024 + (ob ^ (((ob >> 9) & 1) << 5)); }
__host__ __device__ __forceinline__ void stage_rc(int b, int& R, int& C) { const int st = b / 1024, sb = b % 1024, swz = sb ^ (((sb >> 9) & 1) << 5); R = (st >> 1) * 16 + swz / 64; C = (st & 1) * 32 + (swz % 64) / 2; }
__host__ __device__ __forceinline__ int perm32(int rho) { const int n = rho >> 4, i = rho & 15; return 8 * (i >> 2) + 4 * n + (i & 3); }

struct Unit { int pm, pn; };
struct Gemm { const bf16_t* A; const bf16_t* Bt; int M, N, K; };

struct StaticOrder {
    int nM, nN, nwg, G, c;
    __host__ __device__ void init(int M, int N, int G_, int c_) { nM = M / BM; nN = N / BM; nwg = nM * nN; G = G_; c = c_; }
    __host__ __device__ bool next(int i, Unit& u) const {
        const long L = (long)i * G + c; if (L >= nwg) return false;
        int wgid = (int)L; { const int q = nwg / NXCD, r = nwg % NXCD, xcd = wgid % NXCD, off = wgid / NXCD; wgid = (xcd < r ? xcd * (q + 1) : r * (q + 1) + (xcd - r) * q) + off; }
        const int nig = WGM * nN, gid = wgid / nig, fm = gid * WGM, gsz = (nM - fm) < WGM ? (nM - fm) : WGM;
        u.pm = fm + ((wgid % nig) % gsz); u.pn = (wgid % nig) / gsz; return true;
    }
    __device__ __forceinline__ void a_ready(const Unit&) const {}
    __device__ __forceinline__ void done(const Unit&) const {}
};

__device__ __forceinline__ unsigned cvt_pk_bf16(float lo, float hi) { unsigned r; asm volatile("v_cvt_pk_bf16_f32 %0, %1, %2" : "=v"(r) : "v"(lo), "v"(hi)); return r; }
typedef float f32x2 __attribute__((ext_vector_type(2)));
__device__ __forceinline__ f32x2 gelu_pk(f32x2 v) {
    const f32x2 av = __builtin_elementwise_abs(v), d = av * 0.2316418882f + 1.0f;
    f32x2 t; t.x = __builtin_amdgcn_rcpf(d.x); t.y = __builtin_amdgcn_rcpf(d.y);
    f32x2 q = t * 0.5307027145f + (-0.7265760135f); q = q * t + 0.7107068705f; q = q * t + (-0.142248368f); q = q * t + 0.127414796f; q = q * t;
    const f32x2 s = (v * v) * (-0.72134752044f);
    f32x2 e; e.x = __builtin_amdgcn_exp2f(s.x); e.y = __builtin_amdgcn_exp2f(s.y);
    const f32x2 m = v * (q * e), r = v - m;
    f32x2 o; o.x = v.x < 0.f ? m.x : r.x; o.y = v.y < 0.f ? m.y : r.y; return o;
}

template <int ACT  > struct EpiBf16 {
    static constexpr bool PERM = true, AFTER_DRAIN = false; static_assert(ACT == 0 || ACT == 1, "EpiBf16: ACT is 0 (none) or 1 (gelu_pk)");
    bf16_t* O; int ldc; const float* bias; int split_cols; size_t split_stride; float scale0;
    __device__ __forceinline__ void operator()(const f32x4 (&acc)[2][2][4][2], const Unit& u, int wr, int wc, int fr, int fq) const {
        const int row0 = u.pm * BM + wr * 64 + fr; int colt = u.pn * BM; bf16_t* base = O;
        float sc = 1.f; if (split_cols) { const int t = colt / split_cols; base += (size_t)t * split_stride; colt -= t * split_cols; if (t == 0) sc = scale0; }
        const int col0 = colt + wc * 32 + 8 * fq, bcol0 = u.pn * BM + wc * 32 + 8 * fq;
        f32x4 bv[2][2];
#pragma unroll
        for (int bj = 0; bj < 2; ++bj)
#pragma unroll
            for (int n = 0; n < 2; ++n) bv[bj][n] = bias ? *(const f32x4*)(bias + bcol0 + bj * HALF + 4 * n) : (f32x4){0.f, 0.f, 0.f, 0.f};
#pragma unroll
        for (int ai = 0; ai < 2; ++ai)
#pragma unroll
            for (int m = 0; m < 4; ++m) { bf16_t* rowp = base + (size_t)(row0 + ai * HALF + m * 16) * ldc + col0;
#pragma unroll
                for (int bj = 0; bj < 2; ++bj) { f32x4 v0 = acc[ai][bj][m][0] + bv[bj][0], v1 = acc[ai][bj][m][1] + bv[bj][1];
                    if (ACT == 1) { f32x2 a = gelu_pk((f32x2){v0[0], v0[1]}), b = gelu_pk((f32x2){v0[2], v0[3]}), c = gelu_pk((f32x2){v1[0], v1[1]}), d = gelu_pk((f32x2){v1[2], v1[3]});
                        v0 = (f32x4){a.x, a.y, b.x, b.y}; v1 = (f32x4){c.x, c.y, d.x, d.y}; }
                    v0 = v0 * sc; v1 = v1 * sc; u32x4 w; w.x = cvt_pk_bf16(v0[0], v0[1]); w.y = cvt_pk_bf16(v0[2], v0[3]); w.z = cvt_pk_bf16(v1[0], v1[1]); w.w = cvt_pk_bf16(v1[2], v1[3]);
                    *(u32x4*)(rowp + bj * HALF) = w; } }
    }
};
template <int ACT> struct EpiStore {
    static constexpr bool PERM = true, AFTER_DRAIN = false;
    bf16_t* O; int ldc;
    __device__ __forceinline__ void operator()(const f32x4 (&acc)[2][2][4][2], const Unit& u, int wr, int wc, int fr, int fq) const {
        const int row0 = u.pm * BM + wr * 64 + fr; const int col0 = u.pn * BM + wc * 32 + 8 * fq;
#pragma unroll
        for (int ai = 0; ai < 2; ++ai)
#pragma unroll
            for (int m = 0; m < 4; ++m) { bf16_t* rowp = O + (size_t)(row0 + ai * HALF + m * 16) * ldc + col0;
#pragma unroll
                for (int bj = 0; bj < 2; ++bj) { f32x4 v0 = acc[ai][bj][m][0], v1 = acc[ai][bj][m][1];
                    if (ACT == 2) {
#pragma unroll
                        for (int e = 0; e < 4; ++e) { const float a = __builtin_fmaxf(v0[e], 0.f), b = __builtin_fmaxf(v1[e], 0.f); v0[e] = a * a; v1[e] = b * b; } }
                    u32x4 w; w.x = cvt_pk_bf16(v0[0], v0[1]); w.y = cvt_pk_bf16(v0[2], v0[3]); w.z = cvt_pk_bf16(v1[0], v1[1]); w.w = cvt_pk_bf16(v1[2], v1[3]);
                    *(u32x4*)(rowp + bj * HALF) = w; } }
    }
};
struct EpiGlu {
    static constexpr bool PERM = true, AFTER_DRAIN = false;
    const bf16_t* G; const float* bias; bf16_t* O;
    __device__ __forceinline__ void operator()(const f32x4 (&acc)[2][2][4][2], const Unit& u, int wr, int wc, int fr, int fq) const {
        const int row0 = u.pm * BM + wr * 64 + fr; const int col0 = u.pn * BM + wc * 32 + 8 * fq;
#pragma unroll
        for (int ai = 0; ai < 2; ++ai)
#pragma unroll
            for (int m = 0; m < 4; ++m) { const size_t row = (size_t)(row0 + ai * HALF + m * 16);
#pragma unroll
                for (int bj = 0; bj < 2; ++bj) { const int col = col0 + bj * HALF;
                    const u32x4 gw = *(const u32x4*)(G + row * 512 + col);
                    const f32x4 b0 = *(const f32x4*)(bias + col), b1 = *(const f32x4*)(bias + col + 4);
                    const f32x4 z0 = acc[ai][bj][m][0] + b0, z1 = acc[ai][bj][m][1] + b1;
                    float g[8], o[8];
#pragma unroll
                    for (int e = 0; e < 4; ++e) { g[2 * e] = __uint_as_float(gw[e] << 16); g[2 * e + 1] = __uint_as_float(gw[e] & 0xffff0000u); }
#pragma unroll
                    for (int e = 0; e < 4; ++e) {
                        o[e] = g[e] * __builtin_amdgcn_rcpf(1.f + __builtin_amdgcn_exp2f(-1.4426950408889634f * z0[e]));
                        o[4 + e] = g[4 + e] * __builtin_amdgcn_rcpf(1.f + __builtin_amdgcn_exp2f(-1.4426950408889634f * z1[e])); }
                    u32x4 w; w.x = cvt_pk_bf16(o[0], o[1]); w.y = cvt_pk_bf16(o[2], o[3]); w.z = cvt_pk_bf16(o[4], o[5]); w.w = cvt_pk_bf16(o[6], o[7]);
                    *(u32x4*)(O + row * 1024 + 512 + col) = w; } }
    }
};
template <class Epi, class Sched, bool ALIGN_EPI = false, bool SP2 = false>
__device__ __forceinline__ void gemm_phase(PG8_LAS unsigned char* lds, const Gemm g, const Sched& S, const Epi& E) {
    const int tid = threadIdx.x, wid = __builtin_amdgcn_readfirstlane(tid >> 6), lane = tid & 63, wr = wid >> 2, wc = wid & 3, fr = lane & 15, fq = lane >> 4;
    const int K = g.K, nt = K / BK;
    unsigned voffA[2], voffB[2];
#pragma unroll
    for (int i = 0; i < 2; ++i) { int R, C; stage_rc(tid * 16 + i * 8192, R, C); const int Rb = Epi::PERM ? ((R & ~31) + perm32(R & 31)) : R;
        voffA[i] = (unsigned)(R * K + C) * 2u; voffB[i] = (unsigned)(Rb * K + C) * 2u; }
    const size_t kstep = (size_t)(BK * 2);
    const size_t hstep = (size_t)HALF * K * 2;
    const size_t tstep = 2 * hstep;
    const unsigned ldsw = (unsigned)wid * 1024u;
    const int aoff = lds_byte(wr * 64 + fr, fq * 8), boff = lds_byte(wc * 32 + fr, fq * 8);
#define PG8_SA(b, h) (((b) * 2 + (h)) * HTB)
#define PG8_SB(b, h) ((4 + (b) * 2 + (h)) * HTB)
#define PG8_STAGE(bufoff, gbase, voff) do { _Pragma("unroll") for (int _i = 0; _i < 2; ++_i) \
        __builtin_amdgcn_global_load_lds((const unsigned*)((const char*)(gbase) + (voff)[_i]), (PG8_LAS unsigned*)(lds + (bufoff) + ldsw + _i * 8192), 16, 0, 0); } while (0)
#define PG8_LDA(dst, b, h) do { _Pragma("unroll") for (int m = 0; m < 4; ++m) _Pragma("unroll") for (int k = 0; k < 2; ++k) dst[m][k] = *(const PG8_LAS bf16x8*)(lds + PG8_SA(b, h) + aoff + m * 2048 + k * 1024); } while (0)
#define PG8_LDB(dst, b, h) do { _Pragma("unroll") for (int n = 0; n < 2; ++n) _Pragma("unroll") for (int k = 0; k < 2; ++k) dst[n][k] = *(const PG8_LAS bf16x8*)(lds + PG8_SB(b, h) + boff + n * 2048 + k * 1024); } while (0)
#define PG8_MMA(ai, bj, At, Bt) do { __builtin_amdgcn_s_setprio(1); _Pragma("unroll") for (int m = 0; m < 4; ++m) _Pragma("unroll") for (int n = 0; n < 2; ++n) _Pragma("unroll") for (int k = 0; k < 2; ++k) \
        acc[ai][bj][m][n] = __builtin_amdgcn_mfma_f32_16x16x32_bf16(Bt[n][k], At[m][k], acc[ai][bj][m][n], 0, 0, 0); __builtin_amdgcn_s_setprio(0); } while (0)
#define PG8_WAIT_V(n) asm volatile("s_waitcnt vmcnt(" #n ")" ::: "memory")
#define PG8_WAIT_L(n) asm volatile("s_waitcnt lgkmcnt(" #n ")" ::: "memory")
#define PG8_BAR __builtin_amdgcn_s_barrier()
#define PG8_SCHED __builtin_amdgcn_sched_barrier(0)
    Unit cur, nxt; int ui = 0;
    if (!S.next(0, cur)) return;
    f32x4 acc[2][2][4][2];
#pragma unroll
    for (int a = 0; a < 2; ++a)
#pragma unroll
        for (int b = 0; b < 2; ++b)
#pragma unroll
            for (int m = 0; m < 4; ++m)
#pragma unroll
                for (int n = 0; n < 2; ++n) acc[a][b][m][n] = (f32x4){0.f, 0.f, 0.f, 0.f};
    bf16x8 At[4][2], B0[2][2], B1[2][2];
    const char* cA = (const char*)g.A + (size_t)cur.pm * tstep; const char* cB = (const char*)g.Bt + (size_t)cur.pn * tstep;
    S.a_ready(cur);
    if constexpr (SP2) {
        PG8_STAGE(PG8_SB(0, 0), cB, voffB); PG8_STAGE(PG8_SB(0, 1), cB + hstep, voffB); PG8_STAGE(PG8_SA(0, 0), cA, voffA); PG8_STAGE(PG8_SA(0, 1), cA + hstep, voffA);
        if (wr == 1) PG8_BAR;
        PG8_WAIT_V(2); PG8_BAR;
        PG8_STAGE(PG8_SB(1, 0), cB + kstep, voffB); PG8_STAGE(PG8_SA(1, 0), cA + kstep, voffA); PG8_STAGE(PG8_SB(1, 1), cB + hstep + kstep, voffB);
        PG8_WAIT_V(6); PG8_BAR;
    } else {
        PG8_STAGE(PG8_SB(0, 0), cB, voffB); PG8_STAGE(PG8_SA(0, 0), cA, voffA); PG8_STAGE(PG8_SB(0, 1), cB + hstep, voffB); PG8_STAGE(PG8_SA(0, 1), cA + hstep, voffA);
        if (wr == 1) PG8_BAR;
        PG8_WAIT_V(4); PG8_BAR;
        PG8_STAGE(PG8_SB(1, 0), cB + kstep, voffB); PG8_STAGE(PG8_SA(1, 0), cA + kstep, voffA); PG8_STAGE(PG8_SB(1, 1), cB + hstep + kstep, voffB);
        PG8_WAIT_V(6); PG8_BAR;
    }
    for (;;) {
        const bool has_next = S.next(ui + 1, nxt);
        const char* nA = has_next ? (const char*)g.A + (size_t)nxt.pm * tstep : cA; const char* nB = has_next ? (const char*)g.Bt + (size_t)nxt.pn * tstep : cB;
        for (int t = 0; t < nt; t += 2) {
            const bool last = (t == nt - 2);
            const char* a1 = cA + (size_t)(t + 1) * kstep;
            const char* a2 = last ? nA : cA + (size_t)(t + 2) * kstep; const char* b2 = last ? nB : cB + (size_t)(t + 2) * kstep;
            const char* a3 = a2 + kstep; const char* b3 = b2 + kstep;
            if (last && has_next) S.a_ready(nxt);
            if constexpr (SP2) {
            PG8_LDB(B0, 0, 0); PG8_LDB(B1, 0, 1); PG8_SCHED; PG8_LDA(At, 0, 0); PG8_STAGE(PG8_SA(1, 1), a1 + hstep, voffA);
            PG8_WAIT_V(8); PG8_WAIT_L(0); PG8_BAR; PG8_MMA(0, 0, At, B0); PG8_MMA(0, 1, At, B1); PG8_BAR; PG8_SCHED;
            PG8_LDA(At, 0, 1); PG8_STAGE(PG8_SB(0, 0), b2, voffB); PG8_STAGE(PG8_SB(0, 1), b2 + hstep, voffB); PG8_STAGE(PG8_SA(0, 0), a2, voffA);
            PG8_WAIT_V(8); PG8_WAIT_L(0); PG8_BAR; PG8_MMA(1, 0, At, B0); PG8_MMA(1, 1, At, B1); PG8_BAR; PG8_SCHED;
            PG8_LDB(B0, 1, 0); PG8_LDB(B1, 1, 1); PG8_SCHED; PG8_LDA(At, 1, 0); PG8_STAGE(PG8_SA(0, 1), a2 + hstep, voffA);
            PG8_WAIT_V(8); PG8_WAIT_L(0); PG8_BAR; PG8_MMA(0, 0, At, B0); PG8_MMA(0, 1, At, B1); PG8_BAR; PG8_SCHED;
            PG8_LDA(At, 1, 1); PG8_STAGE(PG8_SB(1, 0), b3, voffB); PG8_STAGE(PG8_SB(1, 1), b3 + hstep, voffB); PG8_STAGE(PG8_SA(1, 0), a3, voffA);
            PG8_WAIT_V(8); PG8_WAIT_L(0); PG8_BAR; PG8_MMA(1, 0, At, B0); PG8_MMA(1, 1, At, B1); PG8_BAR; PG8_SCHED;
            } else {
            PG8_LDB(B0, 0, 0); PG8_SCHED; PG8_LDA(At, 0, 0); PG8_STAGE(PG8_SA(1, 1), a1 + hstep, voffA);
            PG8_WAIT_L(8); PG8_BAR; PG8_WAIT_L(0); PG8_MMA(0, 0, At, B0); PG8_BAR; PG8_SCHED;
            PG8_LDB(B1, 0, 1); PG8_STAGE(PG8_SB(0, 0), b2, voffB);
            PG8_BAR; PG8_WAIT_L(0); PG8_MMA(0, 1, At, B1); PG8_BAR;
            PG8_LDA(At, 0, 1); PG8_STAGE(PG8_SA(0, 0), a2, voffA);
            PG8_BAR; PG8_WAIT_L(0); PG8_MMA(1, 0, At, B0); PG8_BAR; PG8_SCHED;
            PG8_STAGE(PG8_SB(0, 1), b2 + hstep, voffB);
            PG8_WAIT_V(6); PG8_BAR; PG8_MMA(1, 1, At, B1); PG8_BAR;
            PG8_LDB(B0, 1, 0); PG8_SCHED; PG8_LDA(At, 1, 0); PG8_STAGE(PG8_SA(0, 1), a2 + hstep, voffA);
            PG8_WAIT_L(8); PG8_BAR; PG8_WAIT_L(0); PG8_MMA(0, 0, At, B0); PG8_BAR; PG8_SCHED;
            PG8_LDB(B1, 1, 1); PG8_STAGE(PG8_SB(1, 0), b3, voffB);
            PG8_BAR; PG8_WAIT_L(0); PG8_MMA(0, 1, At, B1); PG8_BAR;
            PG8_LDA(At, 1, 1); PG8_STAGE(PG8_SA(1, 0), a3, voffA);
            PG8_BAR; PG8_WAIT_L(0); PG8_MMA(1, 0, At, B0); PG8_BAR; PG8_SCHED;
            PG8_STAGE(PG8_SB(1, 1), b3 + hstep, voffB);
            PG8_WAIT_V(6); PG8_BAR; PG8_MMA(1, 1, At, B1); PG8_BAR;
            }
        }
        if constexpr (ALIGN_EPI) { if (wr == 0) PG8_BAR; }
        if constexpr (!Epi::AFTER_DRAIN) { E(acc, cur, wr, wc, fr, fq); S.done(cur); }
        if (!has_next) break;
#pragma unroll
        for (int a = 0; a < 2; ++a)
#pragma unroll
            for (int b = 0; b < 2; ++b)
#pragma unroll
                for (int m = 0; m < 4; ++m)
#pragma unroll
                    for (int n = 0; n < 2; ++n) acc[a][b][m][n] = (f32x4){0.f, 0.f, 0.f, 0.f};
        cur = nxt; cA = nA; cB = nB; ++ui;
        if constexpr (ALIGN_EPI) { if (wr == 1) PG8_BAR; }
    }
    PG8_WAIT_V(0);
    if constexpr (!ALIGN_EPI) { if (wr == 0) PG8_BAR; }
    PG8_BAR;
    if constexpr (Epi::AFTER_DRAIN) { E.fused(acc, cur, wr, wc, fr, fq, lds, wid, lane); S.done(cur); }
#undef PG8_SA
#undef PG8_SB
#undef PG8_STAGE
#undef PG8_LDA
#undef PG8_LDB
#undef PG8_MMA
#undef PG8_WAIT_V
#undef PG8_WAIT_L
#undef PG8_BAR
#undef PG8_SCHED
}
}

#ifndef PG8_SP2
#define PG8_SP2 true
#endif
#ifndef PG8_ALIGN
#define PG8_ALIGN true
#endif
constexpr int NWAVES = 8;
#ifndef MK_N_LAUNCHES
#define MK_N_LAUNCHES 1
#endif
constexpr int N_PHASES = 9;
constexpr int N_LAUNCHES = MK_N_LAUNCHES;

constexpr int DM = 1024, NB = 16, SEQ = 2048, DB = 128, DS = 4, PAST = 16384;
constexpr int MP = NB * SEQ, MS = DB * DS, M = MP + MS;
constexpr int INW = 1280, FF = 4096, SSMW = 512;
constexpr int COL_K = 512, COL_V = 640, COL_U = 768;
constexpr int NG = 32, NP = 64, GC = 16;
constexpr float NORM_EPS = 1e-6f;
constexpr float LOG2E = 1.4426950408889634f;
constexpr size_t O_YP = 0, O_YS = (size_t)MP * DM, O_KWP = O_YS + (size_t)MS * DM, O_VWP = O_KWP + 262144, O_SRP = O_VWP + 262144, O_SIP = O_SRP + 32768,
                 O_KWS = O_SIP + 32768, O_VWS = O_KWS + 2097152, O_SRS = O_VWS + 2097152, O_SIS = O_SRS + 262144, O_END = O_SIS + 262144;
static_assert(O_END == 39387136, "output size");

constexpr size_t MiB = 1u << 20;
constexpr size_t WS_CTL = 0, CTL_ZERO_BYTES = 65536;
constexpr size_t WS_WIN = 2 * MiB, WS_WGLU = 5 * MiB, WS_WOUT = 6 * MiB, WS_WUP = 8 * MiB, WS_WDN = 16 * MiB;
constexpr size_t WS_ROPE = 24 * MiB;
constexpr size_t WS_QKVU = 32 * MiB;
constexpr size_t WS_MIX = 114 * MiB;
constexpr size_t WS_G = 180 * MiB;
constexpr size_t WS_MIXO = 213 * MiB;
constexpr size_t WS_H = 32 * MiB;
constexpr size_t WS_XN = 292 * MiB;
constexpr size_t WS_END = 357 * MiB;
static_assert(WS_QKVU + (size_t)M * INW * 2 <= WS_MIX && WS_MIX + (size_t)M * DM * 2 <= WS_G && WS_G + (size_t)M * SSMW * 2 <= WS_MIXO && WS_MIXO + (size_t)M * DM * 2 <= WS_XN &&
              WS_H + (size_t)M * FF * 2 <= WS_XN && WS_XN + (size_t)M * DM * 2 <= WS_END, "d_ws map");
constexpr int CW_TMO = 0, CW_CODE = 1;
constexpr int CW_BAR = 4096;

constexpr int RING_OFF = 0, RING_BYTES = 131072;
constexpr int LDSCTL_OFF = RING_BYTES, MISC_OFF = LDSCTL_OFF + 320;
constexpr int LDS_BYTES = 147456;
static_assert(MISC_OFF + 128 <= LDS_BYTES, "LDS map");

#define GAS __attribute__((address_space(1)))
#define LAS __attribute__((address_space(3)))
typedef unsigned short bf16;
typedef unsigned v4u __attribute__((ext_vector_type(4)));
typedef unsigned v2u __attribute__((ext_vector_type(2)));
typedef float f32x4 __attribute__((ext_vector_type(4)));
typedef float f32x16 __attribute__((ext_vector_type(16)));
typedef short bf16x8 __attribute__((ext_vector_type(8)));
typedef GAS unsigned gu32;
#define RLX_AGENT __ATOMIC_RELAXED, __HIP_MEMORY_SCOPE_AGENT
#define LDS_WAIT() asm volatile("s_waitcnt lgkmcnt(0)" ::: "memory")
#define VM_WAIT() asm volatile("s_waitcnt vmcnt(0)" ::: "memory")
__device__ __forceinline__ unsigned f2bf(float f) { unsigned u = __builtin_bit_cast(unsigned, f); return (u + 0x7fffu + ((u >> 16) & 1u)) >> 16; }
__device__ __forceinline__ unsigned pk2(float lo, float hi) { return f2bf(lo) | (f2bf(hi) << 16); }
__device__ __forceinline__ float bflo(unsigned w) { return __uint_as_float(w << 16); }
__device__ __forceinline__ float bfhi(unsigned w) { return __uint_as_float(w & 0xffff0000u); }
__device__ __forceinline__ float bf1(bf16 b) { return __uint_as_float((unsigned)b << 16); }
__device__ __forceinline__ void unpack8(const v4u w, float (&o)[8]) {
#pragma unroll
    for (int e = 0; e < 4; ++e) { o[2 * e] = bflo(w[e]); o[2 * e + 1] = bfhi(w[e]); }
}
__device__ __forceinline__ v4u pack8(const float (&o)[8]) { v4u w; w.x = pk2(o[0], o[1]); w.y = pk2(o[2], o[3]); w.z = pk2(o[4], o[5]); w.w = pk2(o[6], o[7]); return w; }
#define XB_TMO      128
#define XB_XCNT(j)  (256  + 64 * (j))
#define XB_XSUB(j)  (1280 + 64 * (j))
#define XB_XGEN(j)  (2304 + 64 * (j))
#define XB_TOP      3328
#define XB_TOPGEN   3392
#define XCD_BAR_WORDS 3456
#define XB_SPIN_CAP (1u << 18)

__device__ __forceinline__ unsigned xb_ld(unsigned* p)              { return __hip_atomic_load(p, __ATOMIC_RELAXED, __HIP_MEMORY_SCOPE_AGENT); }
__device__ __forceinline__ unsigned xb_add(unsigned* p, unsigned v) { return __hip_atomic_fetch_add(p, v, __ATOMIC_RELAXED, __HIP_MEMORY_SCOPE_AGENT); }
__device__ __forceinline__ unsigned xb_xcc_id() { return (unsigned)__builtin_amdgcn_s_getreg((3 << 11) | 20) & 0xFu; }
#define XB_SPIN(cond, bar) do { unsigned _sp = 0; while (cond) { __builtin_amdgcn_s_sleep(1); \
    if ((++_sp & 255u) == 0u) { if (xb_ld(&(bar)[XB_TMO])) break; if (_sp > XB_SPIN_CAP) { atomicAdd(&(bar)[XB_TMO], 1u); break; } } } } while (0)

struct XcdBarrier {
    unsigned* bar; unsigned x;
    volatile LAS unsigned* st;
};

__device__ __forceinline__ XcdBarrier xcd_barrier_post(unsigned* bar, volatile LAS unsigned* st) {
    XcdBarrier b; b.bar = bar; b.x = xb_xcc_id(); b.st = st;
    if (threadIdx.x == 0) (void)xb_add(&bar[XB_XCNT(b.x)], 1u);
    return b;
}
__device__ __forceinline__ void xcd_barrier_complete(unsigned* bar, unsigned x, unsigned& nloc, unsigned& nx) {
    const unsigned G = gridDim.x * gridDim.y * gridDim.z;
    unsigned sum, cnt, mine, sp = 0u;
    for (;;) {
        sum = 0u; cnt = 0u; mine = 0u;
#pragma unroll
        for (unsigned j = 0; j < 16; ++j) { const unsigned c = xb_ld(&bar[XB_XCNT(j)]); sum += c; cnt += (c > 0u) ? 1u : 0u; mine = (j == x) ? c : mine; }
        if (sum == G) break;
        __builtin_amdgcn_s_sleep(1);
        if ((++sp & 255u) == 0u) { if (xb_ld(&bar[XB_TMO])) break; if (sp > XB_SPIN_CAP) { atomicAdd(&bar[XB_TMO], 1u); break; } }
    }
    nloc = mine > 0u ? mine : 1u; nx = cnt > 0u ? cnt : 1u;
}

__device__ __forceinline__ void xcd_barrier(const XcdBarrier& b) {
    asm volatile("s_waitcnt vmcnt(0)" ::: "memory");
    __syncthreads();
    if (threadIdx.x == 0) {
        unsigned* bar = b.bar;
        __builtin_amdgcn_s_waitcnt(0);
        unsigned nloc = b.st[0], nx = b.st[1];
        if (nloc == 0u) { xcd_barrier_complete(bar, b.x, nloc, nx); b.st[0] = nloc; b.st[1] = nx; }
        const unsigned old = xb_add(&bar[XB_XSUB(b.x)], 1u);
        const unsigned gen = old / nloc;
        if (old + 1u == (gen + 1u) * nloc) {
            __builtin_amdgcn_fence(__ATOMIC_RELEASE, "agent");
            asm volatile("s_waitcnt vmcnt(0)" ::: "memory");
            const unsigned og = xb_add(&bar[XB_TOP], 1u);
            const unsigned tg = og / nx;
            if (og + 1u == (tg + 1u) * nx) xb_add(&bar[XB_TOPGEN], 1u);
            else XB_SPIN(xb_ld(&bar[XB_TOPGEN]) == tg, bar);
            __builtin_amdgcn_fence(__ATOMIC_ACQUIRE, "agent");
            xb_add(&bar[XB_XGEN(b.x)], 1u);
            asm volatile("s_waitcnt vmcnt(0)" ::: "memory");
        } else {
            XB_SPIN(xb_ld(&bar[XB_XGEN(b.x)]) == gen, bar);
            __builtin_amdgcn_fence(__ATOMIC_ACQUIRE, "agent");
            asm volatile("s_waitcnt vmcnt(0)" ::: "memory");
        }
    }
    __syncthreads();
}
struct Frame {
    LAS unsigned char* lds;
    volatile LAS unsigned* MISC;
    gu32* ctl;
    int tid, lane, wave;
    int vcu, G;
    const float *x_prompt, *x_sample, *cache_k, *cache_v, *s0_re, *s0_im, *g_mix_pre, *w_in, *sinks, *a_re, *a_im, *log_dt, *b_re, *b_im, *c_re, *c_im, *d_skip,
                *w_glu, *b_glu, *w_out, *g_mix_post, *g_mlp_pre, *w_up, *w_down, *g_mlp_post;
    float* out;
    bf16 *Win_t, *Wglu_t, *Wout_t, *Wup_t, *Wdn_t;
    float* ROPE;
    bf16 *QKVU, *MIX, *GB, *MIXO, *HB, *XN;
};
__device__ __forceinline__ const float* xrow_ptr(const Frame& F, int m) { return m < MP ? F.x_prompt + (size_t)m * DM : F.x_sample + (size_t)(m - MP) * DM; }

__device__ __forceinline__ float wave_sum(float v) {
#pragma unroll
    for (int o = 1; o < 64; o <<= 1) v += __shfl_xor(v, o);
    return v;
}
__device__ __forceinline__ void p0_transpose_item(const float* W, int K, int N, bf16* WT, LAS float* scr, int item, int lane) {
    const int nblk = N / 32, kb = item / nblk, nb = item % nblk, k0 = 64 * kb, n0 = 32 * nb;
#pragma unroll 8
    for (int i = 0; i < 32; ++i) { const int kk = 2 * i + (lane >> 5); scr[kk * 33 + (lane & 31)] = W[(size_t)(k0 + kk) * N + n0 + (lane & 31)]; }
    LDS_WAIT(); asm volatile("" ::: "memory");
    const int c = lane & 7;
#pragma unroll
    for (int j = 0; j < 4; ++j) { const int n = (lane >> 3) + 8 * j; const LAS float* s = scr + (8 * c) * 33 + n;
        v4u o; o.x = pk2(s[0 * 33], s[1 * 33]); o.y = pk2(s[2 * 33], s[3 * 33]); o.z = pk2(s[4 * 33], s[5 * 33]); o.w = pk2(s[6 * 33], s[7 * 33]);
        *(GAS v4u*)(WT + (size_t)(n0 + n) * K + k0 + 8 * c) = o; }
    LDS_WAIT(); asm volatile("" ::: "memory");
}
__device__ __forceinline__ void rms_row_to_bf16(const Frame& F, const float* xrow, const float* gain, bf16* orow) {
    const f32x4* xr = (const f32x4*)xrow + F.lane; const f32x4* gr = (const f32x4*)gain + F.lane;
    f32x4 v[4]; float s = 0.f;
#pragma unroll
    for (int j = 0; j < 4; ++j) { v[j] = xr[64 * j]; s += (v[j].x * v[j].x + v[j].y * v[j].y) + (v[j].z * v[j].z + v[j].w * v[j].w); }
    const float rinv = 1.f / sqrtf(wave_sum(s) * (1.f / DM) + NORM_EPS);
    unsigned long long* o8 = (unsigned long long*)orow + F.lane;
#pragma unroll
    for (int j = 0; j < 4; ++j) { const f32x4 g = gr[64 * j]; const f32x4 y = v[j] * rinv * g;
        o8[64 * j] = (unsigned long long)pk2(y.x, y.y) | ((unsigned long long)pk2(y.z, y.w) << 32); }
}
__device__ __forceinline__ void rope_entry(int pos, int i, float& c, float& s) {
    const double invf = (i == 0) ? 1.0 : (i == 1) ? 0.19392274474868576 : (i == 2) ? 0.03760603093086393 : (i == 3) ? 0.007292664737217109 :
                        (i == 4) ? 0.001414213562373095 : (i == 5) ? 0.0002742481756762073 : (i == 6) ? 5.318295896944988e-05 : 1.031338537721246e-05;
    const double ang = (double)pos * invf;
    const double k = __builtin_rint(ang * 0.15915494309189535);
    double r = __builtin_fma(-k, 6.283185307179586, ang); r = __builtin_fma(-k, 2.4492935982947064e-16, r);
    const double r2 = r * r; double ts = r, ss = r, tc = 1.0, cc = 1.0;
#pragma unroll
    for (int n = 1; n <= 13; ++n) { ts *= -r2 / (double)((2 * n) * (2 * n + 1)); ss += ts; tc *= -r2 / (double)((2 * n - 1) * (2 * n)); cc += tc; }
    c = (float)cc; s = (float)ss;
}
__device__ __forceinline__ void p0_prologue(Frame& F) {
    LAS float* scr = (LAS float*)(F.lds + RING_OFF + F.wave * 16384);
    const int gw = F.vcu * NWAVES + F.wave, NGW = F.G * NWAVES;
    constexpr int I_IN = (DM / 64) * (INW / 32), I_GLU = (SSMW / 64) * (SSMW / 32), I_OUT = (DM / 64) * (DM / 32), I_UP = (DM / 64) * (FF / 32), I_DN = (FF / 64) * (DM / 32);
    constexpr int NITEMS = I_IN + I_GLU + I_OUT + I_UP + I_DN;
    for (int it = gw; it < NITEMS; it += NGW) {
        int r = it;
        if (r < I_IN) { p0_transpose_item(F.w_in, DM, INW, F.Win_t, scr, r, F.lane); continue; } r -= I_IN;
        if (r < I_GLU) { p0_transpose_item(F.w_glu, SSMW, SSMW, F.Wglu_t, scr, r, F.lane); continue; } r -= I_GLU;
        if (r < I_OUT) { p0_transpose_item(F.w_out, DM, DM, F.Wout_t, scr, r, F.lane); continue; } r -= I_OUT;
        if (r < I_UP) { p0_transpose_item(F.w_up, DM, FF, F.Wup_t, scr, r, F.lane); continue; } r -= I_UP;
        p0_transpose_item(F.w_down, FF, DM, F.Wdn_t, scr, r, F.lane);
    }
    for (int m = gw; m < M; m += NGW) rms_row_to_bf16(F, xrow_ptr(F, m), F.g_mix_pre, F.XN + (size_t)m * DM);
    for (int e = (int)blockIdx.x * (NWAVES * 64) + F.tid; e < 2052 * 8; e += F.G * NWAVES * 64) {
        const int idx = e >> 3, i = e & 7; const int pos = idx < SEQ ? idx : PAST + (idx - SEQ);
        float c, s; rope_entry(pos, i, c, s); F.ROPE[idx * 16 + i] = c; F.ROPE[idx * 16 + 8 + i] = s;
    }
}

__device__ __forceinline__ float gelu_tanh(float y) { const float z = 0.7978845608028654f * (y + 0.044715f * y * y * y); return y / (1.f + __expf(-2.f * z)); }
__device__ __forceinline__ void ssm_unit_naive(const Frame& F, int row0, int L, int g, bool has_s0, int sidx, float* out_re, float* out_im) {
    const int p = F.lane;
    const float dt = expf(F.log_dt[g]);
    const float ar = F.a_re[g * NP + p], ai = F.a_im[g * NP + p];
    const float mag = expf(ar * dt);
    const float abr = mag * cosf(ai * dt), abi = mag * sinf(ai * dt);
    const float den = ar * ar + ai * ai, nr = abr - 1.f, ni = abi;
    const float fre = (nr * ar + ni * ai) / den, fim = (ni * ar - nr * ai) / den;
    float bbr[16], bbi[16], cr[16], ci[16];
#pragma unroll
    for (int c = 0; c < 16; ++c) { const float br = F.b_re[(g * NP + p) * GC + c], bi = F.b_im[(g * NP + p) * GC + c];
        bbr[c] = fre * br - fim * bi; bbi[c] = fre * bi + fim * br;
        cr[c] = F.c_re[(g * GC + c) * NP + p]; ci[c] = F.c_im[(g * GC + c) * NP + p]; }
    const int cme = p >> 2;
    const float dsk = F.d_skip[g * GC + cme];
    float xr = has_s0 ? F.s0_re[sidx + p] : 0.f, xi = has_s0 ? F.s0_im[sidx + p] : 0.f;
    const bf16* up = F.QKVU + (size_t)row0 * INW + COL_U + GC * g;
    v4u ua = *(const v4u*)up, ub = *(const v4u*)(up + 8); bf16 ume = up[cme];
    const bool b5 = (p >> 5) & 1, b4 = (p >> 4) & 1, b3 = (p >> 3) & 1, b2 = (p >> 2) & 1;
    for (int l = 0; l < L; ++l) {
        const bf16* un = up + (size_t)(l + 1 < L ? l + 1 : l) * INW;
        const v4u na = *(const v4u*)un, nb = *(const v4u*)(un + 8); const bf16 nme = un[cme];
        float u[16];
#pragma unroll
        for (int e = 0; e < 4; ++e) { u[2 * e] = bflo(ua[e]); u[2 * e + 1] = bfhi(ua[e]); u[8 + 2 * e] = bflo(ub[e]); u[8 + 2 * e + 1] = bfhi(ub[e]); }
        float bur = 0.f, bui = 0.f;
#pragma unroll
        for (int c = 0; c < 16; ++c) { bur += bbr[c] * u[c]; bui += bbi[c] * u[c]; }
        const float nxr = abr * xr - abi * xi + bur, nxi = abr * xi + abi * xr + bui; xr = nxr; xi = nxi;
        float v[16];
#pragma unroll
        for (int c = 0; c < 16; ++c) v[c] = cr[c] * xr - ci[c] * xi;
        float w8[8], w4[4], w2[2];
#pragma unroll
        for (int i = 0; i < 8; ++i) { const float snd = b5 ? v[i] : v[i + 8]; w8[i] = (b5 ? v[i + 8] : v[i]) + __shfl_xor(snd, 32); }
#pragma unroll
        for (int i = 0; i < 4; ++i) { const float snd = b4 ? w8[i] : w8[i + 4]; w4[i] = (b4 ? w8[i + 4] : w8[i]) + __shfl_xor(snd, 16); }
#pragma unroll
        for (int i = 0; i < 2; ++i) { const float snd = b3 ? w4[i] : w4[i + 2]; w2[i] = (b3 ? w4[i + 2] : w4[i]) + __shfl_xor(snd, 8); }
        float y = (b2 ? w2[1] : w2[0]) + __shfl_xor(b2 ? w2[0] : w2[1], 4);
        y += __shfl_xor(y, 1); y += __shfl_xor(y, 2);
        y += dsk * bf1(ume);
        if ((p & 3) == 0) F.GB[(size_t)(row0 + l) * SSMW + GC * g + cme] = (bf16)f2bf(gelu_tanh(y));
        ua = na; ub = nb; ume = nme;
    }
    out_re[sidx + p] = xr; out_im[sidx + p] = xi;
}
__device__ __forceinline__ void ssm_phase_naive(Frame& F) {
    if (F.wave < 2) { for (int id = F.vcu * 2 + F.wave; id < NB * NG; id += F.G * 2) { const int b = id / NG, g = id % NG;
            ssm_unit_naive(F, b * SEQ, SEQ, g, false, (b * NG + g) * NP, F.out + O_SRP, F.out + O_SIP); } }
    else { for (int id = F.vcu * 6 + (F.wave - 2); id < DB * NG; id += F.G * 6) { const int b = id / NG, g = id % NG;
            ssm_unit_naive(F, MP + b * DS, DS, g, true, (b * NG + g) * NP, F.out + O_SRS, F.out + O_SIS); } }
}

__device__ __forceinline__ int crow(int r, int hi) { return (r & 3) + 8 * (r >> 2) + 4 * hi; }
__device__ __forceinline__ void rope8(const v4u mine, const v4u part, const float* tab, int second, float (&o)[8]) {
    const f32x4 c0 = *(const f32x4*)tab, c1 = *(const f32x4*)(tab + 4), s0 = *(const f32x4*)(tab + 8), s1 = *(const f32x4*)(tab + 12);
    float m[8], q[8]; unpack8(mine, m); unpack8(part, q);
    const float sg = second ? 1.f : -1.f;
#pragma unroll
    for (int i = 0; i < 4; ++i) { o[i] = m[i] * c0[i] + sg * q[i] * s0[i]; o[4 + i] = m[4 + i] * c1[i] + sg * q[4 + i] * s1[i]; }
}
constexpr int AT_KL = 0, AT_KROW = 144, AT_VT = 36864, AT_VROW = 520, AT_WSF = 70144;
__device__ __forceinline__ void attn_prompt_unit(Frame& F, int b, int qb, int kvh) {
    LAS unsigned char* KL = F.lds + AT_KL; LAS unsigned char* VT = F.lds + AT_VT;
    LAS float* WSF = (LAS float*)(F.lds + AT_WSF) + F.wave * 64;
    const int lane = F.lane;
#pragma unroll 1
    for (int it = 0; it < 4; ++it) {
        const int idx = F.tid + it * 512, key = idx >> 3, ch = idx & 7;
        const int kpos = qb * 128 - 128 + key;
        v4u kv = (v4u){0u, 0u, 0u, 0u}, vv = (v4u){0u, 0u, 0u, 0u};
        float kf[8];
#pragma unroll
        for (int i = 0; i < 8; ++i) kf[i] = 0.f;
        if (kpos >= 0) {
            const bf16* rowp = F.QKVU + (size_t)(b * SEQ + kpos) * INW;
            kv = *(const v4u*)(rowp + COL_K + kvh * 64 + ch * 8);
            vv = *(const v4u*)(rowp + COL_V + kvh * 64 + ch * 8);
            if (ch < 2) { const v4u pv = *(const v4u*)(rowp + COL_K + kvh * 64 + (ch ^ 1) * 8); rope8(kv, pv, F.ROPE + kpos * 16, ch, kf); kv = pack8(kf); }
            else unpack8(kv, kf);
        }
        *(LAS v4u*)(KL + key * AT_KROW + ch * 16) = kv;
        float vf[8]; unpack8(vv, vf);
#pragma unroll
        for (int i = 0; i < 4; ++i) { *(LAS bf16*)(VT + (ch * 8 + 2 * i) * AT_VROW + key * 2) = (bf16)(vv[i] & 0xffffu); *(LAS bf16*)(VT + (ch * 8 + 2 * i + 1) * AT_VROW + key * 2) = (bf16)(vv[i] >> 16); }
        if (qb == SEQ / 128 - 1 && key >= 128) {
            float* ko = F.out + O_KWP + ((size_t)(b * 128 + (key - 128)) * 2 + kvh) * 64 + ch * 8;
            float* vo = F.out + O_VWP + ((size_t)(b * 128 + (key - 128)) * 2 + kvh) * 64 + ch * 8;
            *(f32x4*)ko = (f32x4){kf[0], kf[1], kf[2], kf[3]}; *(f32x4*)(ko + 4) = (f32x4){kf[4], kf[5], kf[6], kf[7]};
            *(f32x4*)vo = (f32x4){vf[0], vf[1], vf[2], vf[3]}; *(f32x4*)(vo + 4) = (f32x4){vf[4], vf[5], vf[6], vf[7]};
        }
    }
    __syncthreads();
    const int q = lane & 31, h = lane >> 5;
    const int head = kvh * 4 + (F.wave >> 1);
    const float sinkl = F.sinks[head] * LOG2E;
    constexpr float SC = 0.125f * LOG2E;
#pragma unroll 1
    for (int pass = 0; pass < 2; ++pass) {
        const int qs = 2 * (F.wave & 1) + pass, i0 = 32 * qs;
        const int qpos = qb * 128 + i0 + q;
        const bf16* qp = F.QKVU + ((size_t)b * SEQ + qpos) * INW + head * 64;
        bf16x8 qr[4];
#pragma unroll
        for (int d0 = 0; d0 < 4; ++d0) { v4u w = *(const v4u*)(qp + (2 * d0 + h) * 8);
            if (d0 == 0) { const v4u pw = *(const v4u*)(qp + (1 - h) * 8); float o8[8]; rope8(w, pw, F.ROPE + qpos * 16, h, o8); w = pack8(o8); }
            qr[d0] = __builtin_bit_cast(bf16x8, w); }
        f32x16 acc[5];
#pragma unroll
        for (int t = 0; t < 5; ++t) {
#pragma unroll
            for (int r = 0; r < 16; ++r) acc[t][r] = 0.f;
#pragma unroll
            for (int d0 = 0; d0 < 4; ++d0) { const bf16x8 kfrag = *(const LAS bf16x8*)(KL + (32 * (qs + t) + q) * AT_KROW + (2 * d0 + h) * 16);
                acc[t] = __builtin_amdgcn_mfma_f32_32x32x16_bf16(kfrag, qr[d0], acc[t], 0, 0, 0); } }
        float mx = -1e30f;
#pragma unroll
        for (int t = 0; t < 5; ++t)
#pragma unroll
            for (int r = 0; r < 16; ++r) { const int j = 32 * (qs + t) + crow(r, h), i = i0 + q;
                const bool valid = (j > i) && (j <= i + 128) && (qb > 0 || j >= 128);
                const float s = valid ? acc[t][r] * SC : -1e30f; acc[t][r] = s; mx = __builtin_fmaxf(mx, s); }
        mx = __builtin_fmaxf(mx, __shfl_xor(mx, 32)); mx = __builtin_fmaxf(mx, sinkl);
        float sum = 0.f;
#pragma unroll
        for (int t = 0; t < 5; ++t)
#pragma unroll
            for (int r = 0; r < 16; ++r) { const float pp = __builtin_amdgcn_exp2f(acc[t][r] - mx); acc[t][r] = pp; sum += pp; }
        sum += __shfl_xor(sum, 32);
        const float inv = 1.f / (sum + __builtin_amdgcn_exp2f(sinkl - mx));
        if (h == 0) WSF[q] = inv;
        f32x16 o[2];
#pragma unroll
        for (int r = 0; r < 16; ++r) { o[0][r] = 0.f; o[1][r] = 0.f; }
#pragma unroll
        for (int t = 0; t < 5; ++t)
#pragma unroll
            for (int s = 0; s < 2; ++s) {
                v4u pw; pw.x = pk2(acc[t][8 * s + 0], acc[t][8 * s + 1]); pw.y = pk2(acc[t][8 * s + 2], acc[t][8 * s + 3]); pw.z = pk2(acc[t][8 * s + 4], acc[t][8 * s + 5]); pw.w = pk2(acc[t][8 * s + 6], acc[t][8 * s + 7]);
                const bf16x8 pfrag = __builtin_bit_cast(bf16x8, pw);
#pragma unroll
                for (int dh = 0; dh < 2; ++dh) { const LAS unsigned char* vp = VT + (32 * dh + q) * AT_VROW + (32 * (qs + t) + 16 * s + 4 * h) * 2;
                    const v2u lo = *(const LAS v2u*)vp, hi = *(const LAS v2u*)(vp + 16);
                    const v4u vw = (v4u){lo.x, lo.y, hi.x, hi.y};
                    o[dh] = __builtin_amdgcn_mfma_f32_32x32x16_bf16(pfrag, __builtin_bit_cast(bf16x8, vw), o[dh], 0, 0, 0); } }
        LDS_WAIT();
        bf16* op = F.MIX + ((size_t)b * SEQ + qb * 128 + i0) * DM + head * 64 + q;
#pragma unroll
        for (int r = 0; r < 16; ++r) { const float rl = WSF[crow(r, h)];
            op[(size_t)crow(r, h) * DM] = (bf16)f2bf(o[0][r] * rl); op[(size_t)crow(r, h) * DM + 32] = (bf16)f2bf(o[1][r] * rl); }
        LDS_WAIT();
    }
    __syncthreads();
}
constexpr int AS_K = 0, AS_V = 34320, AS_Q = 68640, AS_P = 72736;
__device__ __forceinline__ void attn_sample_unit(Frame& F, int b, int kvh) {
    LAS float* Ks = (LAS float*)(F.lds + AS_K); LAS float* Vs = (LAS float*)(F.lds + AS_V); LAS float* Qs = (LAS float*)(F.lds + AS_Q); LAS float* Ps = (LAS float*)(F.lds + AS_P);
    for (int idx = F.tid; idx < 132 * 64; idx += 512) {
        const int j = idx >> 6, d = idx & 63; float kval, vval;
        if (j < 128) { kval = F.cache_k[((size_t)(b * 128 + j) * 2 + kvh) * 64 + d]; vval = F.cache_v[((size_t)(b * 128 + j) * 2 + kvh) * 64 + d]; }
        else { const int t = j - 128; const bf16* rowp = F.QKVU + (size_t)(MP + b * DS + t) * INW;
            kval = bf1(rowp[COL_K + kvh * 64 + d]); vval = bf1(rowp[COL_V + kvh * 64 + d]);
            if (d < 16) { const float* tab = F.ROPE + (SEQ + t) * 16; const float other = bf1(rowp[COL_K + kvh * 64 + (d ^ 8)]);
                kval = (d < 8) ? kval * tab[d] - other * tab[8 + d] : kval * tab[d - 8] + other * tab[8 + d - 8]; } }
        Ks[j * 65 + d] = kval; Vs[j * 65 + d] = vval;
        if (j >= DS) { F.out[O_KWS + ((size_t)(b * 128 + (j - DS)) * 2 + kvh) * 64 + d] = kval; F.out[O_VWS + ((size_t)(b * 128 + (j - DS)) * 2 + kvh) * 64 + d] = vval; }
    }
    for (int idx = F.tid; idx < 16 * 64; idx += 512) {
        const int r = idx >> 6, d = idx & 63, t = r >> 2, head = kvh * 4 + (r & 3);
        const bf16* rowp = F.QKVU + (size_t)(MP + b * DS + t) * INW + head * 64;
        float qv = bf1(rowp[d]);
        if (d < 16) { const float* tab = F.ROPE + (SEQ + t) * 16; const float other = bf1(rowp[d ^ 8]);
            qv = (d < 8) ? qv * tab[d] - other * tab[8 + d] : qv * tab[d - 8] + other * tab[8 + d - 8]; }
        Qs[r * 64 + d] = qv;
    }
    __syncthreads();
    const int r = F.tid >> 5, ln = F.tid & 31, t = r >> 2, head = kvh * 4 + (r & 3);
    {
        float s[5]; float mx = -1e30f;
#pragma unroll
        for (int k = 0; k < 5; ++k) { const int j = ln + 32 * k; float a = -1e30f;
            if (j < 132) { float d_ = 0.f;
#pragma unroll 8
                for (int d = 0; d < 64; ++d) d_ += Qs[r * 64 + d] * Ks[j * 65 + d];
                const bool valid = (j > t) && (j <= t + 128); a = valid ? d_ * 0.125f : -1e30f; }
            s[k] = a; mx = __builtin_fmaxf(mx, a); }
#pragma unroll
        for (int o = 16; o >= 1; o >>= 1) mx = __builtin_fmaxf(mx, __shfl_xor(mx, o));
        const float sk = F.sinks[head]; mx = __builtin_fmaxf(mx, sk);
        float sum = 0.f;
#pragma unroll
        for (int k = 0; k < 5; ++k) { s[k] = __expf(s[k] - mx); sum += s[k]; }
#pragma unroll
        for (int o = 16; o >= 1; o >>= 1) sum += __shfl_xor(sum, o);
        const float inv = 1.f / (sum + __expf(sk - mx));
#pragma unroll
        for (int k = 0; k < 5; ++k) { const int j = ln + 32 * k; if (j < 132) Ps[r * 136 + j] = s[k] * inv; }
    }
    __syncthreads();
    {
        float o0 = 0.f, o1 = 0.f;
#pragma unroll 4
        for (int j = 0; j < 132; ++j) { const float pj = Ps[r * 136 + j]; o0 += pj * Vs[j * 65 + ln]; o1 += pj * Vs[j * 65 + ln + 32]; }
        bf16* op = F.MIX + (size_t)(MP + b * DS + t) * DM + head * 64;
        op[ln] = (bf16)f2bf(o0); op[ln + 32] = (bf16)f2bf(o1);
    }
    __syncthreads();
}
__device__ __forceinline__ void attn_phase(Frame& F) {
    for (int id = F.vcu; id < NB * 16 * 2; id += F.G) { const int kvh = id & 1, qb = (id >> 1) & 15, b = id >> 5; attn_prompt_unit(F, b, qb, kvh); }
    for (int id = F.vcu; id < DB * 2; id += F.G) attn_sample_unit(F, id >> 1, id & 1);
}

__device__ __forceinline__ void rowpass1(Frame& F) {
    const int gw = F.vcu * NWAVES + F.wave, NGW = F.G * NWAVES;
    for (int m = gw; m < M; m += NGW) {
        const f32x4* xr = (const f32x4*)xrow_ptr(F, m) + F.lane; const v2u* mr = (const v2u*)(F.MIXO + (size_t)m * DM) + F.lane;
        f32x4 xv[4], mv[4]; float s = 0.f;
#pragma unroll
        for (int j = 0; j < 4; ++j) { xv[j] = xr[64 * j]; const v2u w = mr[64 * j]; mv[j] = (f32x4){bflo(w.x), bfhi(w.x), bflo(w.y), bfhi(w.y)};
            s += (mv[j].x * mv[j].x + mv[j].y * mv[j].y) + (mv[j].z * mv[j].z + mv[j].w * mv[j].w); }
        const float rinv = 1.f / sqrtf(wave_sum(s) * (1.f / DM) + NORM_EPS);
        float s2 = 0.f; f32x4* orow = (f32x4*)(F.out + (size_t)m * DM) + F.lane;
#pragma unroll
        for (int j = 0; j < 4; ++j) { const f32x4 g = ((const f32x4*)F.g_mix_post + F.lane)[64 * j]; xv[j] = xv[j] + mv[j] * rinv * g; orow[64 * j] = xv[j];
            s2 += (xv[j].x * xv[j].x + xv[j].y * xv[j].y) + (xv[j].z * xv[j].z + xv[j].w * xv[j].w); }
        const float rinv2 = 1.f / sqrtf(wave_sum(s2) * (1.f / DM) + NORM_EPS);
        unsigned long long* o8 = (unsigned long long*)(F.XN + (size_t)m * DM) + F.lane;
#pragma unroll
        for (int j = 0; j < 4; ++j) { const f32x4 g = ((const f32x4*)F.g_mlp_pre + F.lane)[64 * j]; const f32x4 y = xv[j] * rinv2 * g;
            o8[64 * j] = (unsigned long long)pk2(y.x, y.y) | ((unsigned long long)pk2(y.z, y.w) << 32); }
    }
}
__device__ __forceinline__ void rowpass2(Frame& F) {
    const int gw = F.vcu * NWAVES + F.wave, NGW = F.G * NWAVES;
    for (int m = gw; m < M; m += NGW) {
        f32x4* orow = (f32x4*)(F.out + (size_t)m * DM) + F.lane; const v2u* mr = (const v2u*)(F.XN + (size_t)m * DM) + F.lane;
        f32x4 xv[4], mv[4]; float s = 0.f;
#pragma unroll
        for (int j = 0; j < 4; ++j) { xv[j] = orow[64 * j]; const v2u w = mr[64 * j]; mv[j] = (f32x4){bflo(w.x), bfhi(w.x), bflo(w.y), bfhi(w.y)};
            s += (mv[j].x * mv[j].x + mv[j].y * mv[j].y) + (mv[j].z * mv[j].z + mv[j].w * mv[j].w); }
        const float rinv = 1.f / sqrtf(wave_sum(s) * (1.f / DM) + NORM_EPS);
#pragma unroll
        for (int j = 0; j < 4; ++j) { const f32x4 g = ((const f32x4*)F.g_mlp_post + F.lane)[64 * j]; orow[64 * j] = xv[j] + mv[j] * rinv * g; }
    }
}

struct Args { const float* in[25]; float* out; unsigned char* ws; int ph_lo, ph_hi; };
__global__ void __launch_bounds__(NWAVES * 64, 2) mega_fwd(Args args) {
    extern __shared__ __attribute__((aligned(16))) unsigned char lds[];
    Frame F;
    F.lds = (LAS unsigned char*)lds;
    F.MISC = (volatile LAS unsigned*)(F.lds + MISC_OFF);
    F.tid = threadIdx.x; F.lane = F.tid & 63; F.wave = __builtin_amdgcn_readfirstlane(F.tid >> 6);
    F.G = gridDim.x; { const int bx = blockIdx.x; F.vcu = (F.G % 8 == 0) ? (bx % 8) * (F.G / 8) + bx / 8 : bx; }
    unsigned char* ws = args.ws;
    F.ctl = (gu32*)(ws + WS_CTL);
    F.x_prompt = args.in[0]; F.x_sample = args.in[1]; F.cache_k = args.in[2]; F.cache_v = args.in[3]; F.s0_re = args.in[4]; F.s0_im = args.in[5]; F.g_mix_pre = args.in[6];
    F.w_in = args.in[7]; F.sinks = args.in[8]; F.a_re = args.in[9]; F.a_im = args.in[10]; F.log_dt = args.in[11]; F.b_re = args.in[12]; F.b_im = args.in[13];
    F.c_re = args.in[14]; F.c_im = args.in[15]; F.d_skip = args.in[16]; F.w_glu = args.in[17]; F.b_glu = args.in[18]; F.w_out = args.in[19]; F.g_mix_post = args.in[20];
    F.g_mlp_pre = args.in[21]; F.w_up = args.in[22]; F.w_down = args.in[23]; F.g_mlp_post = args.in[24]; F.out = args.out;
    F.Win_t = (bf16*)(ws + WS_WIN); F.Wglu_t = (bf16*)(ws + WS_WGLU); F.Wout_t = (bf16*)(ws + WS_WOUT); F.Wup_t = (bf16*)(ws + WS_WUP); F.Wdn_t = (bf16*)(ws + WS_WDN);
    F.ROPE = (float*)(ws + WS_ROPE);
    F.QKVU = (bf16*)(ws + WS_QKVU); F.MIX = (bf16*)(ws + WS_MIX); F.GB = (bf16*)(ws + WS_G); F.MIXO = (bf16*)(ws + WS_MIXO); F.HB = (bf16*)(ws + WS_H); F.XN = (bf16*)(ws + WS_XN);
    for (int u = F.tid; u < (LDS_BYTES - LDSCTL_OFF) / 4; u += NWAVES * 64) ((LAS unsigned*)(F.lds + LDSCTL_OFF))[u] = 0u;
    __syncthreads();
    const int lo = args.ph_lo, hi = args.ph_hi;
    const bool use_bar = (hi - lo) > 1;
    XcdBarrier bar; bar.bar = (unsigned*)(F.ctl + CW_BAR); bar.x = 0; bar.st = nullptr;
    if (use_bar) bar = xcd_barrier_post((unsigned*)(F.ctl + CW_BAR), F.MISC + 8);
#ifndef PHASE_MASK
#define PHASE_MASK 0x1ff
#endif
#define IN(k) (((PHASE_MASK >> (k)) & 1) && lo <= (k) && (k) < hi)
#define SEAM(k) do { if (IN(k) && IN((k) + 1)) xcd_barrier(bar); } while (0)

    if (IN(0)) { p0_prologue(F); SEAM(0); }
    if (IN(1)) {
        pg8::Gemm g{F.XN, F.Win_t, M, INW, DM}; pg8::StaticOrder S; S.init(M, INW, F.G, (int)blockIdx.x);
        pg8::EpiStore<0> E{F.QKVU, INW};
        pg8::gemm_phase<pg8::EpiStore<0>, pg8::StaticOrder, PG8_ALIGN, PG8_SP2>(F.lds + RING_OFF, g, S, E);
        SEAM(1);
    }
    if (IN(2)) { ssm_phase_naive(F); __syncthreads(); attn_phase(F); SEAM(2); }
    if (IN(3)) {
        pg8::Gemm g{F.GB, F.Wglu_t, M, SSMW, SSMW}; pg8::StaticOrder S; S.init(M, SSMW, F.G, (int)blockIdx.x);
        pg8::EpiGlu E{F.GB, F.b_glu, F.MIX};
        pg8::gemm_phase<pg8::EpiGlu, pg8::StaticOrder, PG8_ALIGN, PG8_SP2>(F.lds + RING_OFF, g, S, E);
        SEAM(3);
    }
    if (IN(4)) {
        pg8::Gemm g{F.MIX, F.Wout_t, M, DM, DM}; pg8::StaticOrder S; S.init(M, DM, F.G, (int)blockIdx.x);
        pg8::EpiStore<0> E{F.MIXO, DM};
        pg8::gemm_phase<pg8::EpiStore<0>, pg8::StaticOrder, PG8_ALIGN, PG8_SP2>(F.lds + RING_OFF, g, S, E);
        SEAM(4);
    }
    if (IN(5)) { rowpass1(F); SEAM(5); }
    if (IN(6)) {
        pg8::Gemm g{F.XN, F.Wup_t, M, FF, DM}; pg8::StaticOrder S; S.init(M, FF, F.G, (int)blockIdx.x);
        pg8::EpiStore<2> E{F.HB, FF};
        pg8::gemm_phase<pg8::EpiStore<2>, pg8::StaticOrder, PG8_ALIGN, PG8_SP2>(F.lds + RING_OFF, g, S, E);
        SEAM(6);
    }
    if (IN(7)) {
        pg8::Gemm g{F.HB, F.Wdn_t, M, DM, FF}; pg8::StaticOrder S; S.init(M, DM, F.G, (int)blockIdx.x);
        pg8::EpiStore<0> E{F.XN, DM};
        pg8::gemm_phase<pg8::EpiStore<0>, pg8::StaticOrder, PG8_ALIGN, PG8_SP2>(F.lds + RING_OFF, g, S, E);
        SEAM(7);
    }
    if (IN(8)) { rowpass2(F); }
#undef IN
#undef SEAM
}

extern "C" void kernel_launch(void* const* d_in, const int* in_sizes, int n_in, void* d_out, int out_size, void* d_ws, size_t ws_size, hipStream_t stream) {
    static int grid = 0;
    if (grid == 0) {
        if (n_in != 25 || out_size != (int)O_END || ws_size < WS_END) { fprintf(stderr, "kernel_launch: unexpected shapes n_in %d out %d ws %zu\n", n_in, out_size, ws_size); grid = -1; return; }
        int dev = 0, cus = 0, per_cu = 0;
        if (hipGetDevice(&dev) != hipSuccess || hipDeviceGetAttribute(&cus, hipDeviceAttributeMultiprocessorCount, dev) != hipSuccess) { grid = -1; return; }
        if (hipFuncSetAttribute((const void*)mega_fwd, hipFuncAttributeMaxDynamicSharedMemorySize, LDS_BYTES) != hipSuccess) { fprintf(stderr, "kernel_launch: hipFuncSetAttribute failed\n"); grid = -1; return; }
        if (hipOccupancyMaxActiveBlocksPerMultiprocessor(&per_cu, (const void*)mega_fwd, NWAVES * 64, LDS_BYTES) != hipSuccess || per_cu < 1)
            fprintf(stderr, "kernel_launch: note: occupancy query reports %d workgroups per CU\n", per_cu);
        (void)hipGetLastError();
        grid = cus;
    }
    if (grid < 0) return;
    if (hipMemsetAsync((char*)d_ws + WS_CTL, 0, CTL_ZERO_BYTES, stream) != hipSuccess) { fprintf(stderr, "kernel_launch: memset failed\n"); return; }
    Args a{};
    for (int i = 0; i < 25; ++i) a.in[i] = (const float*)d_in[i];
    a.out = (float*)d_out; a.ws = (unsigned char*)d_ws;
    if (N_LAUNCHES == 1) { a.ph_lo = 0; a.ph_hi = N_PHASES; hipLaunchKernelGGL(mega_fwd, dim3(grid), dim3(NWAVES * 64), LDS_BYTES, stream, a); }
    else { for (int li = 0; li < N_PHASES; ++li) { a.ph_lo = li; a.ph_hi = li + 1; hipLaunchKernelGGL(mega_fwd, dim3(grid), dim3(NWAVES * 64), LDS_BYTES, stream, a); } }
    const hipError_t le = hipPeekAtLastError();
    if (le != hipSuccess) fprintf(stderr, "kernel_launch: launch failed: %s\n", hipGetErrorName(le));
}
```

```cpp
#include <hip/hip_runtime.h>
#include <cstdio>
#include <cstdint>
namespace pg8 {
#define PG8_LAS __attribute__((address_space(3)))
typedef unsigned short bf16_t;
typedef short bf16x8 __attribute__((ext_vector_type(8)));
typedef float f32x4 __attribute__((ext_vector_type(4)));
typedef unsigned u32x4 __attribute__((ext_vector_type(4)));
constexpr int BM = 256, BK = 64, HALF = 128, HTB = HALF * BK * 2  , STAGE_BYTES = 8 * HTB, NXCD = 8, WGM = 8;

__host__ __device__ __forceinline__ int lds_byte(int r, int c) { const int st = (r >> 4) * 2 + (c >> 5), rr = r & 15, cc = c & 31, ob = rr * 64 + cc * 2; return st * 1024 + (ob ^ (((ob >> 9) & 1) << 5)); }
__host__ __device__ __forceinline__ void stage_rc(int b, int& R, int& C) { const int st = b / 1024, sb = b % 1024, swz = sb ^ (((sb >> 9) & 1) << 5); R = (st >> 1) * 16 + swz / 64; C = (st & 1) * 32 + (swz % 64) / 2; }
__host__ __device__ __forceinline__ int perm32(int rho) { const int n = rho >> 4, i = rho & 15; return 8 * (i >> 2) + 4 * n + (i & 3); }

struct Unit { int pm, pn; };
struct Gemm { const bf16_t* A; const bf16_t* Bt; int M, N, K; };

struct StaticOrder {
    int nM, nN, nwg, G, c;
    __host__ __device__ void init(int M, int N, int G_, int c_) { nM = M / BM; nN = N / BM; nwg = nM * nN; G = G_; c = c_; }
    __host__ __device__ bool next(int i, Unit& u) const {
        const long L = (long)i * G + c; if (L >= nwg) return false;
        int wgid = (int)L; { const int q = nwg / NXCD, r = nwg % NXCD, xcd = wgid % NXCD, off = wgid / NXCD; wgid = (xcd < r ? xcd * (q + 1) : r * (q + 1) + (xcd - r) * q) + off; }
        const int nig = WGM * nN, gid = wgid / nig, fm = gid * WGM, gsz = (nM - fm) < WGM ? (nM - fm) : WGM;
        u.pm = fm + ((wgid % nig) % gsz); u.pn = (wgid % nig) / gsz; return true;
    }
    __device__ __forceinline__ void a_ready(const Unit&) const {}
    __device__ __forceinline__ void done(const Unit&) const {}
};

__device__ __forceinline__ unsigned cvt_pk_bf16(float lo, float hi) { unsigned r; asm volatile("v_cvt_pk_bf16_f32 %0, %1, %2" : "=v"(r) : "v"(lo), "v"(hi)); return r; }
typedef float f32x2 __attribute__((ext_vector_type(2)));
__device__ __forceinline__ f32x2 gelu_pk(f32x2 v) {
    const f32x2 av = __builtin_elementwise_abs(v), d = av * 0.2316418882f + 1.0f;
    f32x2 t; t.x = __builtin_amdgcn_rcpf(d.x); t.y = __builtin_amdgcn_rcpf(d.y);
    f32x2 q = t * 0.5307027145f + (-0.7265760135f); q = q * t + 0.7107068705f; q = q * t + (-0.142248368f); q = q * t + 0.127414796f; q = q * t;
    const f32x2 s = (v * v) * (-0.72134752044f);
    f32x2 e; e.x = __builtin_amdgcn_exp2f(s.x); e.y = __builtin_amdgcn_exp2f(s.y);
    const f32x2 m = v * (q * e), r = v - m;
    f32x2 o; o.x = v.x < 0.f ? m.x : r.x; o.y = v.y < 0.f ? m.y : r.y; return o;
}

template <int ACT  > struct EpiBf16 {
    static constexpr bool PERM = true, AFTER_DRAIN = false; static_assert(ACT == 0 || ACT == 1, "EpiBf16: ACT is 0 (none) or 1 (gelu_pk)");
    bf16_t* O; int ldc; const float* bias; int split_cols; size_t split_stride; float scale0;
    __device__ __forceinline__ void operator()(const f32x4 (&acc)[2][2][4][2], const Unit& u, int wr, int wc, int fr, int fq) const {
        const int row0 = u.pm * BM + wr * 64 + fr; int colt = u.pn * BM; bf16_t* base = O;
        float sc = 1.f; if (split_cols) { const int t = colt / split_cols; base += (size_t)t * split_stride; colt -= t * split_cols; if (t == 0) sc = scale0; }
        const int col0 = colt + wc * 32 + 8 * fq, bcol0 = u.pn * BM + wc * 32 + 8 * fq;
        f32x4 bv[2][2];
#pragma unroll
        for (int bj = 0; bj < 2; ++bj)
#pragma unroll
            for (int n = 0; n < 2; ++n) bv[bj][n] = bias ? *(const f32x4*)(bias + bcol0 + bj * HALF + 4 * n) : (f32x4){0.f, 0.f, 0.f, 0.f};
#pragma unroll
        for (int ai = 0; ai < 2; ++ai)
#pragma unroll
            for (int m = 0; m < 4; ++m) { bf16_t* rowp = base + (size_t)(row0 + ai * HALF + m * 16) * ldc + col0;
#pragma unroll
                for (int bj = 0; bj < 2; ++bj) { f32x4 v0 = acc[ai][bj][m][0] + bv[bj][0], v1 = acc[ai][bj][m][1] + bv[bj][1];
                    if (ACT == 1) { f32x2 a = gelu_pk((f32x2){v0[0], v0[1]}), b = gelu_pk((f32x2){v0[2], v0[3]}), c = gelu_pk((f32x2){v1[0], v1[1]}), d = gelu_pk((f32x2){v1[2], v1[3]});
                        v0 = (f32x4){a.x, a.y, b.x, b.y}; v1 = (f32x4){c.x, c.y, d.x, d.y}; }
                    v0 = v0 * sc; v1 = v1 * sc; u32x4 w; w.x = cvt_pk_bf16(v0[0], v0[1]); w.y = cvt_pk_bf16(v0[2], v0[3]); w.z = cvt_pk_bf16(v1[0], v1[1]); w.w = cvt_pk_bf16(v1[2], v1[3]);
                    *(u32x4*)(rowp + bj * HALF) = w; } }
    }
};
template <int ACT> struct EpiStore {
    static constexpr bool PERM = true, AFTER_DRAIN = false;
    bf16_t* O; int ldc;
    __device__ __forceinline__ void operator()(const f32x4 (&acc)[2][2][4][2], const Unit& u, int wr, int wc, int fr, int fq) const {
        const int row0 = u.pm * BM + wr * 64 + fr; const int col0 = u.pn * BM + wc * 32 + 8 * fq;
#pragma unroll
        for (int ai = 0; ai < 2; ++ai)
#pragma unroll
            for (int m = 0; m < 4; ++m) { bf16_t* rowp = O + (size_t)(row0 + ai * HALF + m * 16) * ldc + col0;
#pragma unroll
                for (int bj = 0; bj < 2; ++bj) { f32x4 v0 = acc[ai][bj][m][0], v1 = acc[ai][bj][m][1];
                    if (ACT == 2) {
#pragma unroll
                        for (int e = 0; e < 4; ++e) { const float a = __builtin_fmaxf(v0[e], 0.f), b = __builtin_fmaxf(v1[e], 0.f); v0[e] = a * a; v1[e] = b * b; } }
                    u32x4 w; w.x = cvt_pk_bf16(v0[0], v0[1]); w.y = cvt_pk_bf16(v0[2], v0[3]); w.z = cvt_pk_bf16(v1[0], v1[1]); w.w = cvt_pk_bf16(v1[2], v1[3]);
                    *(u32x4*)(rowp + bj * HALF) = w; } }
    }
};
struct EpiGlu {
    static constexpr bool PERM = true, AFTER_DRAIN = false;
    const bf16_t* G; const float* bias; bf16_t* O;
    __device__ __forceinline__ void operator()(const f32x4 (&acc)[2][2][4][2], const Unit& u, int wr, int wc, int fr, int fq) const {
        const int row0 = u.pm * BM + wr * 64 + fr; const int col0 = u.pn * BM + wc * 32 + 8 * fq;
#pragma unroll
        for (int ai = 0; ai < 2; ++ai)
#pragma unroll
            for (int m = 0; m < 4; ++m) { const size_t row = (size_t)(row0 + ai * HALF + m * 16);
#pragma unroll
                for (int bj = 0; bj < 2; ++bj) { const int col = col0 + bj * HALF;
                    const u32x4 gw = *(const u32x4*)(G + row * 512 + col);
                    const f32x4 b0 = *(const f32x4*)(bias + col), b1 = *(const f32x4*)(bias + col + 4);
                    const f32x4 z0 = acc[ai][bj][m][0] + b0, z1 = acc[ai][bj][m][1] + b1;
                    float g[8], o[8];
#pragma unroll
                    for (int e = 0; e < 4; ++e) { g[2 * e] = __uint_as_float(gw[e] << 16); g[2 * e + 1] = __uint_as_float(gw[e] & 0xffff0000u); }
#pragma unroll
                    for (int e = 0; e < 4; ++e) {
                        o[e] = g[e] * __builtin_amdgcn_rcpf(1.f + __builtin_amdgcn_exp2f(-1.4426950408889634f * z0[e]));
                        o[4 + e] = g[4 + e] * __builtin_amdgcn_rcpf(1.f + __builtin_amdgcn_exp2f(-1.4426950408889634f * z1[e])); }
                    u32x4 w; w.x = cvt_pk_bf16(o[0], o[1]); w.y = cvt_pk_bf16(o[2], o[3]); w.z = cvt_pk_bf16(o[4], o[5]); w.w = cvt_pk_bf16(o[6], o[7]);
                    *(u32x4*)(O + row * 1024 + 512 + col) = w; } }
    }
};
template <class Epi, class Sched, bool ALIGN_EPI = false, bool SP2 = false>
__device__ __forceinline__ void gemm_phase(PG8_LAS unsigned char* lds, const Gemm g, const Sched& S, const Epi& E) {
    const int tid = threadIdx.x, wid = __builtin_amdgcn_readfirstlane(tid >> 6), lane = tid & 63, wr = wid >> 2, wc = wid & 3, fr = lane & 15, fq = lane >> 4;
    const int K = g.K, nt = K / BK;
    unsigned voffA[2], voffB[2];
#pragma unroll
    for (int i = 0; i < 2; ++i) { int R, C; stage_rc(tid * 16 + i * 8192, R, C); const int Rb = Epi::PERM ? ((R & ~31) + perm32(R & 31)) : R;
        voffA[i] = (unsigned)(R * K + C) * 2u; voffB[i] = (unsigned)(Rb * K + C) * 2u; }
    const size_t kstep = (size_t)(BK * 2);
    const size_t hstep = (size_t)HALF * K * 2;
    const size_t tstep = 2 * hstep;
    const unsigned ldsw = (unsigned)wid * 1024u;
    const int aoff = lds_byte(wr * 64 + fr, fq * 8), boff = lds_byte(wc * 32 + fr, fq * 8);
#define PG8_SA(b, h) (((b) * 2 + (h)) * HTB)
#define PG8_SB(b, h) ((4 + (b) * 2 + (h)) * HTB)
#define PG8_STAGE(bufoff, gbase, voff) do { _Pragma("unroll") for (int _i = 0; _i < 2; ++_i) \
        __builtin_amdgcn_global_load_lds((const unsigned*)((const char*)(gbase) + (voff)[_i]), (PG8_LAS unsigned*)(lds + (bufoff) + ldsw + _i * 8192), 16, 0, 0); } while (0)
#define PG8_LDA(dst, b, h) do { _Pragma("unroll") for (int m = 0; m < 4; ++m) _Pragma("unroll") for (int k = 0; k < 2; ++k) dst[m][k] = *(const PG8_LAS bf16x8*)(lds + PG8_SA(b, h) + aoff + m * 2048 + k * 1024); } while (0)
#define PG8_LDB(dst, b, h) do { _Pragma("unroll") for (int n = 0; n < 2; ++n) _Pragma("unroll") for (int k = 0; k < 2; ++k) dst[n][k] = *(const PG8_LAS bf16x8*)(lds + PG8_SB(b, h) + boff + n * 2048 + k * 1024); } while (0)
#define PG8_MMA(ai, bj, At, Bt) do { __builtin_amdgcn_s_setprio(1); _Pragma("unroll") for (int m = 0; m < 4; ++m) _Pragma("unroll") for (int n = 0; n < 2; ++n) _Pragma("unroll") for (int k = 0; k < 2; ++k) \
        acc[ai][bj][m][n] = __builtin_amdgcn_mfma_f32_16x16x32_bf16(Bt[n][k], At[m][k], acc[ai][bj][m][n], 0, 0, 0); __builtin_amdgcn_s_setprio(0); } while (0)
#define PG8_WAIT_V(n) asm volatile("s_waitcnt vmcnt(" #n ")" ::: "memory")
#define PG8_WAIT_L(n) asm volatile("s_waitcnt lgkmcnt(" #n ")" ::: "memory")
#define PG8_BAR __builtin_amdgcn_s_barrier()
#define PG8_SCHED __builtin_amdgcn_sched_barrier(0)
    Unit cur, nxt; int ui = 0;
    if (!S.next(0, cur)) return;
    f32x4 acc[2][2][4][2];
#pragma unroll
    for (int a = 0; a < 2; ++a)
#pragma unroll
        for (int b = 0; b < 2; ++b)
#pragma unroll
            for (int m = 0; m < 4; ++m)
#pragma unroll
                for (int n = 0; n < 2; ++n) acc[a][b][m][n] = (f32x4){0.f, 0.f, 0.f, 0.f};
    bf16x8 At[4][2], B0[2][2], B1[2][2];
    const char* cA = (const char*)g.A + (size_t)cur.pm * tstep; const char* cB = (const char*)g.Bt + (size_t)cur.pn * tstep;
    S.a_ready(cur);
    if constexpr (SP2) {
        PG8_STAGE(PG8_SB(0, 0), cB, voffB); PG8_STAGE(PG8_SB(0, 1), cB + hstep, voffB); PG8_STAGE(PG8_SA(0, 0), cA, voffA); PG8_STAGE(PG8_SA(0, 1), cA + hstep, voffA);
        if (wr == 1) PG8_BAR;
        PG8_WAIT_V(2); PG8_BAR;
        PG8_STAGE(PG8_SB(1, 0), cB + kstep, voffB); PG8_STAGE(PG8_SA(1, 0), cA + kstep, voffA); PG8_STAGE(PG8_SB(1, 1), cB + hstep + kstep, voffB);
        PG8_WAIT_V(6); PG8_BAR;
    } else {
        PG8_STAGE(PG8_SB(0, 0), cB, voffB); PG8_STAGE(PG8_SA(0, 0), cA, voffA); PG8_STAGE(PG8_SB(0, 1), cB + hstep, voffB); PG8_STAGE(PG8_SA(0, 1), cA + hstep, voffA);
        if (wr == 1) PG8_BAR;
        PG8_WAIT_V(4); PG8_BAR;
        PG8_STAGE(PG8_SB(1, 0), cB + kstep, voffB); PG8_STAGE(PG8_SA(1, 0), cA + kstep, voffA); PG8_STAGE(PG8_SB(1, 1), cB + hstep + kstep, voffB);
        PG8_WAIT_V(6); PG8_BAR;
    }
    for (;;) {
        const bool has_next = S.next(ui + 1, nxt);
        const char* nA = has_next ? (const char*)g.A + (size_t)nxt.pm * tstep : cA; const char* nB = has_next ? (const char*)g.Bt + (size_t)nxt.pn * tstep : cB;
        for (int t = 0; t < nt; t += 2) {
            const bool last = (t == nt - 2);
            const char* a1 = cA + (size_t)(t + 1) * kstep;
            const char* a2 = last ? nA : cA + (size_t)(t + 2) * kstep; const char* b2 = last ? nB : cB + (size_t)(t + 2) * kstep;
            const char* a3 = a2 + kstep; const char* b3 = b2 + kstep;
            if (last && has_next) S.a_ready(nxt);
            if constexpr (SP2) {
            PG8_LDB(B0, 0, 0); PG8_LDB(B1, 0, 1); PG8_SCHED; PG8_LDA(At, 0, 0); PG8_STAGE(PG8_SA(1, 1), a1 + hstep, voffA);
            PG8_WAIT_V(8); PG8_WAIT_L(0); PG8_BAR; PG8_MMA(0, 0, At, B0); PG8_MMA(0, 1, At, B1); PG8_BAR; PG8_SCHED;
            PG8_LDA(At, 0, 1); PG8_STAGE(PG8_SB(0, 0), b2, voffB); PG8_STAGE(PG8_SB(0, 1), b2 + hstep, voffB); PG8_STAGE(PG8_SA(0, 0), a2, voffA);
            PG8_WAIT_V(8); PG8_WAIT_L(0); PG8_BAR; PG8_MMA(1, 0, At, B0); PG8_MMA(1, 1, At, B1); PG8_BAR; PG8_SCHED;
            PG8_LDB(B0, 1, 0); PG8_LDB(B1, 1, 1); PG8_SCHED; PG8_LDA(At, 1, 0); PG8_STAGE(PG8_SA(0, 1), a2 + hstep, voffA);
            PG8_WAIT_V(8); PG8_WAIT_L(0); PG8_BAR; PG8_MMA(0, 0, At, B0); PG8_MMA(0, 1, At, B1); PG8_BAR; PG8_SCHED;
            PG8_LDA(At, 1, 1); PG8_STAGE(PG8_SB(1, 0), b3, voffB); PG8_STAGE(PG8_SB(1, 1), b3 + hstep, voffB); PG8_STAGE(PG8_SA(1, 0), a3, voffA);
            PG8_WAIT_V(8); PG8_WAIT_L(0); PG8_BAR; PG8_MMA(1, 0, At, B0); PG8_MMA(1, 1, At, B1); PG8_BAR; PG8_SCHED;
            } else {
            PG8_LDB(B0, 0, 0); PG8_SCHED; PG8_LDA(At, 0, 0); PG8_STAGE(PG8_SA(1, 1), a1 + hstep, voffA);
            PG8_WAIT_L(8); PG8_BAR; PG8_WAIT_L(0); PG8_MMA(0, 0, At, B0); PG8_BAR; PG8_SCHED;
            PG8_LDB(B1, 0, 1); PG8_STAGE(PG8_SB(0, 0), b2, voffB);
            PG8_BAR; PG8_WAIT_L(0); PG8_MMA(0, 1, At, B1); PG8_BAR;
            PG8_LDA(At, 0, 1); PG8_STAGE(PG8_SA(0, 0), a2, voffA);
            PG8_BAR; PG8_WAIT_L(0); PG8_MMA(1, 0, At, B0); PG8_BAR; PG8_SCHED;
            PG8_STAGE(PG8_SB(0, 1), b2 + hstep, voffB);
            PG8_WAIT_V(6); PG8_BAR; PG8_MMA(1, 1, At, B1); PG8_BAR;
            PG8_LDB(B0, 1, 0); PG8_SCHED; PG8_LDA(At, 1, 0); PG8_STAGE(PG8_SA(0, 1), a2 + hstep, voffA);
            PG8_WAIT_L(8); PG8_BAR; PG8_WAIT_L(0); PG8_MMA(0, 0, At, B0); PG8_BAR; PG8_SCHED;
            PG8_LDB(B1, 1, 1); PG8_STAGE(PG8_SB(1, 0), b3, voffB);
            PG8_BAR; PG8_WAIT_L(0); PG8_MMA(0, 1, At, B1); PG8_BAR;
            PG8_LDA(At, 1, 1); PG8_STAGE(PG8_SA(1, 0), a3, voffA);
            PG8_BAR; PG8_WAIT_L(0); PG8_MMA(1, 0, At, B0); PG8_BAR; PG8_SCHED;
            PG8_STAGE(PG8_SB(1, 1), b3 + hstep, voffB);
            PG8_WAIT_V(6); PG8_BAR; PG8_MMA(1, 1, At, B1); PG8_BAR;
            }
        }
        if constexpr (ALIGN_EPI) { if (wr == 0) PG8_BAR; }
        if constexpr (!Epi::AFTER_DRAIN) { E(acc, cur, wr, wc, fr, fq); S.done(cur); }
        if (!has_next) break;
#pragma unroll
        for (int a = 0; a < 2; ++a)
#pragma unroll
            for (int b = 0; b < 2; ++b)
#pragma unroll
                for (int m = 0; m < 4; ++m)
#pragma unroll
                    for (int n = 0; n < 2; ++n) acc[a][b][m][n] = (f32x4){0.f, 0.f, 0.f, 0.f};
        cur = nxt; cA = nA; cB = nB; ++ui;
        if constexpr (ALIGN_EPI) { if (wr == 1) PG8_BAR; }
    }
    PG8_WAIT_V(0);
    if constexpr (!ALIGN_EPI) { if (wr == 0) PG8_BAR; }
    PG8_BAR;
    if constexpr (Epi::AFTER_DRAIN) { E.fused(acc, cur, wr, wc, fr, fq, lds, wid, lane); S.done(cur); }
#undef PG8_SA
#undef PG8_SB
#undef PG8_STAGE
#undef PG8_LDA
#undef PG8_LDB
#undef PG8_MMA
#undef PG8_WAIT_V
#undef PG8_WAIT_L
#undef PG8_BAR
#undef PG8_SCHED
}
}

#ifndef PG8_SP2
#define PG8_SP2 true
#endif
#ifndef PG8_ALIGN
#define PG8_ALIGN true
#endif
constexpr int NWAVES = 8;
#ifndef MK_N_LAUNCHES
#define MK_N_LAUNCHES 1
#endif
constexpr int N_PHASES = 9;
constexpr int N_LAUNCHES = MK_N_LAUNCHES;

constexpr int DM = 1024, NB = 16, SEQ = 2048, DB = 128, DS = 4, PAST = 16384;
constexpr int MP = NB * SEQ, MS = DB * DS, M = MP + MS;
constexpr int INW = 1280, FF = 4096, SSMW = 512;
constexpr int COL_K = 512, COL_V = 640, COL_U = 768;
constexpr int NG = 32, NP = 64, GC = 16;
constexpr float NORM_EPS = 1e-6f;
constexpr float LOG2E = 1.4426950408889634f;
constexpr size_t O_YP = 0, O_YS = (size_t)MP * DM, O_KWP = O_YS + (size_t)MS * DM, O_VWP = O_KWP + 262144, O_SRP = O_VWP + 262144, O_SIP = O_SRP + 32768,
                 O_KWS = O_SIP + 32768, O_VWS = O_KWS + 2097152, O_SRS = O_VWS + 2097152, O_SIS = O_SRS + 262144, O_END = O_SIS + 262144;
static_assert(O_END == 39387136, "output size");

constexpr size_t MiB = 1u << 20;
constexpr size_t WS_CTL = 0, CTL_ZERO_BYTES = 65536;
constexpr size_t WS_WIN = 2 * MiB, WS_WGLU = 5 * MiB, WS_WOUT = 6 * MiB, WS_WUP = 8 * MiB, WS_WDN = 16 * MiB;
constexpr size_t WS_ROPE = 24 * MiB;
constexpr size_t WS_SSM_FT = 25 * MiB, WS_SSM_SF = WS_SSM_FT + 512 * 1024, WS_SSM_CF = WS_SSM_SF + 2 * MiB, WS_SSM_AT = WS_SSM_CF + 2 * MiB;
constexpr size_t WS_QKVU = 32 * MiB;
constexpr size_t WS_MIX = 114 * MiB;
constexpr size_t WS_G = 180 * MiB;
constexpr size_t WS_MIXO = 213 * MiB;
constexpr size_t WS_H = 32 * MiB;
constexpr size_t WS_XN = 292 * MiB;
constexpr size_t WS_END = 357 * MiB;
static_assert(WS_QKVU + (size_t)M * INW * 2 <= WS_MIX && WS_MIX + (size_t)M * DM * 2 <= WS_G && WS_G + (size_t)M * SSMW * 2 <= WS_MIXO && WS_MIXO + (size_t)M * DM * 2 <= WS_XN &&
              WS_H + (size_t)M * FF * 2 <= WS_XN && WS_XN + (size_t)M * DM * 2 <= WS_END, "d_ws map");
constexpr int CW_TMO = 0, CW_CODE = 1;
constexpr int CW_BAR = 4096;

constexpr int RING_OFF = 0, RING_BYTES = 131072;
constexpr int LDSCTL_OFF = RING_BYTES, MISC_OFF = LDSCTL_OFF + 320;
constexpr int LDS_BYTES = 147456;
static_assert(MISC_OFF + 128 <= LDS_BYTES, "LDS map");

#define GAS __attribute__((address_space(1)))
#define LAS __attribute__((address_space(3)))
typedef unsigned short bf16;
typedef unsigned v4u __attribute__((ext_vector_type(4)));
typedef unsigned v2u __attribute__((ext_vector_type(2)));
typedef float f32x4 __attribute__((ext_vector_type(4)));
typedef float f32x16 __attribute__((ext_vector_type(16)));
typedef short bf16x8 __attribute__((ext_vector_type(8)));
typedef GAS unsigned gu32;
#define RLX_AGENT __ATOMIC_RELAXED, __HIP_MEMORY_SCOPE_AGENT
#define LDS_WAIT() asm volatile("s_waitcnt lgkmcnt(0)" ::: "memory")
#define VM_WAIT() asm volatile("s_waitcnt vmcnt(0)" ::: "memory")
__device__ __forceinline__ unsigned f2bf(float f) { unsigned u = __builtin_bit_cast(unsigned, f); return (u + 0x7fffu + ((u >> 16) & 1u)) >> 16; }
__device__ __forceinline__ unsigned pk2(float lo, float hi) { return f2bf(lo) | (f2bf(hi) << 16); }
__device__ __forceinline__ float bflo(unsigned w) { return __uint_as_float(w << 16); }
__device__ __forceinline__ float bfhi(unsigned w) { return __uint_as_float(w & 0xffff0000u); }
__device__ __forceinline__ float bf1(bf16 b) { return __uint_as_float((unsigned)b << 16); }
__device__ __forceinline__ void unpack8(const v4u w, float (&o)[8]) {
#pragma unroll
    for (int e = 0; e < 4; ++e) { o[2 * e] = bflo(w[e]); o[2 * e + 1] = bfhi(w[e]); }
}
__device__ __forceinline__ v4u pack8(const float (&o)[8]) { v4u w; w.x = pk2(o[0], o[1]); w.y = pk2(o[2], o[3]); w.z = pk2(o[4], o[5]); w.w = pk2(o[6], o[7]); return w; }
#define XB_TMO      128
#define XB_XCNT(j)  (256  + 64 * (j))
#define XB_XSUB(j)  (1280 + 64 * (j))
#define XB_XGEN(j)  (2304 + 64 * (j))
#define XB_TOP      3328
#define XB_TOPGEN   3392
#define XCD_BAR_WORDS 3456
#define XB_SPIN_CAP (1u << 18)

__device__ __forceinline__ unsigned xb_ld(unsigned* p)              { return __hip_atomic_load(p, __ATOMIC_RELAXED, __HIP_MEMORY_SCOPE_AGENT); }
__device__ __forceinline__ unsigned xb_add(unsigned* p, unsigned v) { return __hip_atomic_fetch_add(p, v, __ATOMIC_RELAXED, __HIP_MEMORY_SCOPE_AGENT); }
__device__ __forceinline__ unsigned xb_xcc_id() { return (unsigned)__builtin_amdgcn_s_getreg((3 << 11) | 20) & 0xFu; }
#define XB_SPIN(cond, bar) do { unsigned _sp = 0; while (cond) { __builtin_amdgcn_s_sleep(1); \
    if ((++_sp & 255u) == 0u) { if (xb_ld(&(bar)[XB_TMO])) break; if (_sp > XB_SPIN_CAP) { atomicAdd(&(bar)[XB_TMO], 1u); break; } } } } while (0)

struct XcdBarrier {
    unsigned* bar; unsigned x;
    volatile LAS unsigned* st;
};

__device__ __forceinline__ XcdBarrier xcd_barrier_post(unsigned* bar, volatile LAS unsigned* st) {
    XcdBarrier b; b.bar = bar; b.x = xb_xcc_id(); b.st = st;
    if (threadIdx.x == 0) (void)xb_add(&bar[XB_XCNT(b.x)], 1u);
    return b;
}
__device__ __forceinline__ void xcd_barrier_complete(unsigned* bar, unsigned x, unsigned& nloc, unsigned& nx) {
    const unsigned G = gridDim.x * gridDim.y * gridDim.z;
    unsigned sum, cnt, mine, sp = 0u;
    for (;;) {
        sum = 0u; cnt = 0u; mine = 0u;
#pragma unroll
        for (unsigned j = 0; j < 16; ++j) { const unsigned c = xb_ld(&bar[XB_XCNT(j)]); sum += c; cnt += (c > 0u) ? 1u : 0u; mine = (j == x) ? c : mine; }
        if (sum == G) break;
        __builtin_amdgcn_s_sleep(1);
        if ((++sp & 255u) == 0u) { if (xb_ld(&bar[XB_TMO])) break; if (sp > XB_SPIN_CAP) { atomicAdd(&bar[XB_TMO], 1u); break; } }
    }
    nloc = mine > 0u ? mine : 1u; nx = cnt > 0u ? cnt : 1u;
}

__device__ __forceinline__ void xcd_barrier(const XcdBarrier& b) {
    asm volatile("s_waitcnt vmcnt(0)" ::: "memory");
    __syncthreads();
    if (threadIdx.x == 0) {
        unsigned* bar = b.bar;
        __builtin_amdgcn_s_waitcnt(0);
        unsigned nloc = b.st[0], nx = b.st[1];
        if (nloc == 0u) { xcd_barrier_complete(bar, b.x, nloc, nx); b.st[0] = nloc; b.st[1] = nx; }
        const unsigned old = xb_add(&bar[XB_XSUB(b.x)], 1u);
        const unsigned gen = old / nloc;
        if (old + 1u == (gen + 1u) * nloc) {
            __builtin_amdgcn_fence(__ATOMIC_RELEASE, "agent");
            asm volatile("s_waitcnt vmcnt(0)" ::: "memory");
            const unsigned og = xb_add(&bar[XB_TOP], 1u);
            const unsigned tg = og / nx;
            if (og + 1u == (tg + 1u) * nx) xb_add(&bar[XB_TOPGEN], 1u);
            else XB_SPIN(xb_ld(&bar[XB_TOPGEN]) == tg, bar);
            __builtin_amdgcn_fence(__ATOMIC_ACQUIRE, "agent");
            xb_add(&bar[XB_XGEN(b.x)], 1u);
            asm volatile("s_waitcnt vmcnt(0)" ::: "memory");
        } else {
            XB_SPIN(xb_ld(&bar[XB_XGEN(b.x)]) == gen, bar);
            __builtin_amdgcn_fence(__ATOMIC_ACQUIRE, "agent");
            asm volatile("s_waitcnt vmcnt(0)" ::: "memory");
        }
    }
    __syncthreads();
}
struct Frame {
    LAS unsigned char* lds;
    volatile LAS unsigned* MISC;
    gu32* ctl;
    int tid, lane, wave;
    int vcu, G;
    const float *x_prompt, *x_sample, *cache_k, *cache_v, *s0_re, *s0_im, *g_mix_pre, *w_in, *sinks, *a_re, *a_im, *log_dt, *b_re, *b_im, *c_re, *c_im, *d_skip,
                *w_glu, *b_glu, *w_out, *g_mix_post, *g_mlp_pre, *w_up, *w_down, *g_mlp_post;
    float* out;
    bf16 *Win_t, *Wglu_t, *Wout_t, *Wup_t, *Wdn_t;
    float* ROPE;
    bf16 *SFT, *SSF, *SCF; float* SAT;
    bf16 *QKVU, *MIX, *GB, *MIXO, *HB, *XN;
};
__device__ __forceinline__ const float* xrow_ptr(const Frame& F, int m) { return m < MP ? F.x_prompt + (size_t)m * DM : F.x_sample + (size_t)(m - MP) * DM; }

__device__ __forceinline__ int crow(int r, int hi) { return (r & 3) + 8 * (r >> 2) + 4 * hi; }

__device__ __forceinline__ float wave_sum(float v) {
#pragma unroll
    for (int o = 1; o < 64; o <<= 1) v += __shfl_xor(v, o);
    return v;
}
__device__ __forceinline__ void p0_transpose_item(const float* W, int K, int N, bf16* WT, LAS float* scr, int item, int lane) {
    const int nblk = N / 32, kb = item / nblk, nb = item % nblk, k0 = 64 * kb, n0 = 32 * nb;
#pragma unroll 8
    for (int i = 0; i < 32; ++i) { const int kk = 2 * i + (lane >> 5); scr[kk * 33 + (lane & 31)] = W[(size_t)(k0 + kk) * N + n0 + (lane & 31)]; }
    LDS_WAIT(); asm volatile("" ::: "memory");
    const int c = lane & 7;
#pragma unroll
    for (int j = 0; j < 4; ++j) { const int n = (lane >> 3) + 8 * j; const LAS float* s = scr + (8 * c) * 33 + n;
        v4u o; o.x = pk2(s[0 * 33], s[1 * 33]); o.y = pk2(s[2 * 33], s[3 * 33]); o.z = pk2(s[4 * 33], s[5 * 33]); o.w = pk2(s[6 * 33], s[7 * 33]);
        *(GAS v4u*)(WT + (size_t)(n0 + n) * K + k0 + 8 * c) = o; }
    LDS_WAIT(); asm volatile("" ::: "memory");
}
__device__ __forceinline__ void rms_row_to_bf16(const Frame& F, const float* xrow, const float* gain, bf16* orow) {
    const f32x4* xr = (const f32x4*)xrow + F.lane; const f32x4* gr = (const f32x4*)gain + F.lane;
    f32x4 v[4]; float s = 0.f;
#pragma unroll
    for (int j = 0; j < 4; ++j) { v[j] = xr[64 * j]; s += (v[j].x * v[j].x + v[j].y * v[j].y) + (v[j].z * v[j].z + v[j].w * v[j].w); }
    const float rinv = 1.f / sqrtf(wave_sum(s) * (1.f / DM) + NORM_EPS);
    unsigned long long* o8 = (unsigned long long*)orow + F.lane;
#pragma unroll
    for (int j = 0; j < 4; ++j) { const f32x4 g = gr[64 * j]; const f32x4 y = v[j] * rinv * g;
        o8[64 * j] = (unsigned long long)pk2(y.x, y.y) | ((unsigned long long)pk2(y.z, y.w) << 32); }
}
__device__ __forceinline__ void rope_entry(int pos, int i, float& c, float& s) {
    const double invf = (i == 0) ? 1.0 : (i == 1) ? 0.19392274474868576 : (i == 2) ? 0.03760603093086393 : (i == 3) ? 0.007292664737217109 :
                        (i == 4) ? 0.001414213562373095 : (i == 5) ? 0.0002742481756762073 : (i == 6) ? 5.318295896944988e-05 : 1.031338537721246e-05;
    const double ang = (double)pos * invf;
    const double k = __builtin_rint(ang * 0.15915494309189535);
    double r = __builtin_fma(-k, 6.283185307179586, ang); r = __builtin_fma(-k, 2.4492935982947064e-16, r);
    const double r2 = r * r; double ts = r, ss = r, tc = 1.0, cc = 1.0;
#pragma unroll
    for (int n = 1; n <= 13; ++n) { ts *= -r2 / (double)((2 * n) * (2 * n + 1)); ss += ts; tc *= -r2 / (double)((2 * n - 1) * (2 * n)); cc += tc; }
    c = (float)cc; s = (float)ss;
}
__device__ __forceinline__ void p0_prologue(Frame& F) {
    LAS float* scr = (LAS float*)(F.lds + RING_OFF + F.wave * 16384);
    const int gw = F.vcu * NWAVES + F.wave, NGW = F.G * NWAVES;
    constexpr int I_IN = (DM / 64) * (INW / 32), I_GLU = (SSMW / 64) * (SSMW / 32), I_OUT = (DM / 64) * (DM / 32), I_UP = (DM / 64) * (FF / 32), I_DN = (FF / 64) * (DM / 32);
    constexpr int NITEMS = I_IN + I_GLU + I_OUT + I_UP + I_DN;
    for (int it = gw; it < NITEMS; it += NGW) {
        int r = it;
        if (r < I_IN) { p0_transpose_item(F.w_in, DM, INW, F.Win_t, scr, r, F.lane); continue; } r -= I_IN;
        if (r < I_GLU) { p0_transpose_item(F.w_glu, SSMW, SSMW, F.Wglu_t, scr, r, F.lane); continue; } r -= I_GLU;
        if (r < I_OUT) { p0_transpose_item(F.w_out, DM, DM, F.Wout_t, scr, r, F.lane); continue; } r -= I_OUT;
        if (r < I_UP) { p0_transpose_item(F.w_up, DM, FF, F.Wup_t, scr, r, F.lane); continue; } r -= I_UP;
        p0_transpose_item(F.w_down, FF, DM, F.Wdn_t, scr, r, F.lane);
    }
    for (int m = gw; m < M; m += NGW) rms_row_to_bf16(F, xrow_ptr(F, m), F.g_mix_pre, F.XN + (size_t)m * DM);
    for (int e = (int)blockIdx.x * (NWAVES * 64) + F.tid; e < 2052 * 8; e += F.G * NWAVES * 64) {
        const int idx = e >> 3, i = e & 7; const int pos = idx < SEQ ? idx : PAST + (idx - SEQ);
        float c, s; rope_entry(pos, i, c, s); F.ROPE[idx * 16 + i] = c; F.ROPE[idx * 16 + 8 + i] = s;
    }
}

__device__ __forceinline__ float gelu_tanh(float y) { const float z = 0.7978845608028654f * (y + 0.044715f * y * y * y); return y / (1.f + __expf(-2.f * z)); }
__device__ __forceinline__ void ssm_unit_naive(const Frame& F, int row0, int L, int g, bool has_s0, int sidx, float* out_re, float* out_im) {
    const int p = F.lane;
    const float dt = expf(F.log_dt[g]);
    const float ar = F.a_re[g * NP + p], ai = F.a_im[g * NP + p];
    const float mag = expf(ar * dt);
    const float abr = mag * cosf(ai * dt), abi = mag * sinf(ai * dt);
    const float den = ar * ar + ai * ai, nr = abr - 1.f, ni = abi;
    const float fre = (nr * ar + ni * ai) / den, fim = (ni * ar - nr * ai) / den;
    float bbr[16], bbi[16], cr[16], ci[16];
#pragma unroll
    for (int c = 0; c < 16; ++c) { const float br = F.b_re[(g * NP + p) * GC + c], bi = F.b_im[(g * NP + p) * GC + c];
        bbr[c] = fre * br - fim * bi; bbi[c] = fre * bi + fim * br;
        cr[c] = F.c_re[(g * GC + c) * NP + p]; ci[c] = F.c_im[(g * GC + c) * NP + p]; }
    const int cme = p >> 2;
    const float dsk = F.d_skip[g * GC + cme];
    float xr = has_s0 ? F.s0_re[sidx + p] : 0.f, xi = has_s0 ? F.s0_im[sidx + p] : 0.f;
    const bf16* up = F.QKVU + (size_t)row0 * INW + COL_U + GC * g;
    v4u ua = *(const v4u*)up, ub = *(const v4u*)(up + 8); bf16 ume = up[cme];
    const bool b5 = (p >> 5) & 1, b4 = (p >> 4) & 1, b3 = (p >> 3) & 1, b2 = (p >> 2) & 1;
    for (int l = 0; l < L; ++l) {
        const bf16* un = up + (size_t)(l + 1 < L ? l + 1 : l) * INW;
        const v4u na = *(const v4u*)un, nb = *(const v4u*)(un + 8); const bf16 nme = un[cme];
        float u[16];
#pragma unroll
        for (int e = 0; e < 4; ++e) { u[2 * e] = bflo(ua[e]); u[2 * e + 1] = bfhi(ua[e]); u[8 + 2 * e] = bflo(ub[e]); u[8 + 2 * e + 1] = bfhi(ub[e]); }
        float bur = 0.f, bui = 0.f;
#pragma unroll
        for (int c = 0; c < 16; ++c) { bur += bbr[c] * u[c]; bui += bbi[c] * u[c]; }
        const float nxr = abr * xr - abi * xi + bur, nxi = abr * xi + abi * xr + bui; xr = nxr; xi = nxi;
        float v[16];
#pragma unroll
        for (int c = 0; c < 16; ++c) v[c] = cr[c] * xr - ci[c] * xi;
        float w8[8], w4[4], w2[2];
#pragma unroll
        for (int i = 0; i < 8; ++i) { const float snd = b5 ? v[i] : v[i + 8]; w8[i] = (b5 ? v[i + 8] : v[i]) + __shfl_xor(snd, 32); }
#pragma unroll
        for (int i = 0; i < 4; ++i) { const float snd = b4 ? w8[i] : w8[i + 4]; w4[i] = (b4 ? w8[i + 4] : w8[i]) + __shfl_xor(snd, 16); }
#pragma unroll
        for (int i = 0; i < 2; ++i) { const float snd = b3 ? w4[i] : w4[i + 2]; w2[i] = (b3 ? w4[i + 2] : w4[i]) + __shfl_xor(snd, 8); }
        float y = (b2 ? w2[1] : w2[0]) + __shfl_xor(b2 ? w2[0] : w2[1], 4);
        y += __shfl_xor(y, 1); y += __shfl_xor(y, 2);
        y += dsk * bf1(ume);
        if ((p & 3) == 0) F.GB[(size_t)(row0 + l) * SSMW + GC * g + cme] = (bf16)f2bf(gelu_tanh(y));
        ua = na; ub = nb; ume = nme;
    }
    out_re[sidx + p] = xr; out_im[sidx + p] = xi;
}
__device__ __forceinline__ void ssm_phase_naive(Frame& F) {
    if (F.wave < 2) { for (int id = F.vcu * 2 + F.wave; id < NB * NG; id += F.G * 2) { const int b = id / NG, g = id % NG;
            ssm_unit_naive(F, b * SEQ, SEQ, g, false, (b * NG + g) * NP, F.out + O_SRP, F.out + O_SIP); } }
    else { for (int id = F.vcu * 6 + (F.wave - 2); id < DB * NG; id += F.G * 6) { const int b = id / NG, g = id % NG;
            ssm_unit_naive(F, MP + b * DS, DS, g, true, (b * NG + g) * NP, F.out + O_SRS, F.out + O_SIS); } }
}

__device__ __forceinline__ void rope8(const v4u mine, const v4u part, const float* tab, int second, float (&o)[8]) {
    const f32x4 c0 = *(const f32x4*)tab, c1 = *(const f32x4*)(tab + 4), s0 = *(const f32x4*)(tab + 8), s1 = *(const f32x4*)(tab + 12);
    float m[8], q[8]; unpack8(mine, m); unpack8(part, q);
    const float sg = second ? 1.f : -1.f;
#pragma unroll
    for (int i = 0; i < 4; ++i) { o[i] = m[i] * c0[i] + sg * q[i] * s0[i]; o[4 + i] = m[4 + i] * c1[i] + sg * q[4 + i] * s1[i]; }
}
constexpr int AT_KL = 0, AT_KROW = 144, AT_VT = 36864, AT_VROW = 520, AT_WSF = 70144;
__device__ __forceinline__ void attn_prompt_unit(Frame& F, int b, int qb, int kvh) {
    LAS unsigned char* KL = F.lds + AT_KL; LAS unsigned char* VT = F.lds + AT_VT;
    LAS float* WSF = (LAS float*)(F.lds + AT_WSF) + F.wave * 64;
    const int lane = F.lane;
#pragma unroll 1
    for (int it = 0; it < 4; ++it) {
        const int idx = F.tid + it * 512, key = idx >> 3, ch = idx & 7;
        const int kpos = qb * 128 - 128 + key;
        v4u kv = (v4u){0u, 0u, 0u, 0u}, vv = (v4u){0u, 0u, 0u, 0u};
        float kf[8];
#pragma unroll
        for (int i = 0; i < 8; ++i) kf[i] = 0.f;
        if (kpos >= 0) {
            const bf16* rowp = F.QKVU + (size_t)(b * SEQ + kpos) * INW;
            kv = *(const v4u*)(rowp + COL_K + kvh * 64 + ch * 8);
            vv = *(const v4u*)(rowp + COL_V + kvh * 64 + ch * 8);
            if (ch < 2) { const v4u pv = *(const v4u*)(rowp + COL_K + kvh * 64 + (ch ^ 1) * 8); rope8(kv, pv, F.ROPE + kpos * 16, ch, kf); kv = pack8(kf); }
            else unpack8(kv, kf);
        }
        *(LAS v4u*)(KL + key * AT_KROW + ch * 16) = kv;
        float vf[8]; unpack8(vv, vf);
#pragma unroll
        for (int i = 0; i < 4; ++i) { *(LAS bf16*)(VT + (ch * 8 + 2 * i) * AT_VROW + key * 2) = (bf16)(vv[i] & 0xffffu); *(LAS bf16*)(VT + (ch * 8 + 2 * i + 1) * AT_VROW + key * 2) = (bf16)(vv[i] >> 16); }
        if (qb == SEQ / 128 - 1 && key >= 128) {
            float* ko = F.out + O_KWP + ((size_t)(b * 128 + (key - 128)) * 2 + kvh) * 64 + ch * 8;
            float* vo = F.out + O_VWP + ((size_t)(b * 128 + (key - 128)) * 2 + kvh) * 64 + ch * 8;
            *(f32x4*)ko = (f32x4){kf[0], kf[1], kf[2], kf[3]}; *(f32x4*)(ko + 4) = (f32x4){kf[4], kf[5], kf[6], kf[7]};
            *(f32x4*)vo = (f32x4){vf[0], vf[1], vf[2], vf[3]}; *(f32x4*)(vo + 4) = (f32x4){vf[4], vf[5], vf[6], vf[7]};
        }
    }
    __syncthreads();
    const int q = lane & 31, h = lane >> 5;
    const int head = kvh * 4 + (F.wave >> 1);
    const float sinkl = F.sinks[head] * LOG2E;
    constexpr float SC = 0.125f * LOG2E;
#pragma unroll 1
    for (int pass = 0; pass < 2; ++pass) {
        const int qs = 2 * (F.wave & 1) + pass, i0 = 32 * qs;
        const int qpos = qb * 128 + i0 + q;
        const bf16* qp = F.QKVU + ((size_t)b * SEQ + qpos) * INW + head * 64;
        bf16x8 qr[4];
#pragma unroll
        for (int d0 = 0; d0 < 4; ++d0) { v4u w = *(const v4u*)(qp + (2 * d0 + h) * 8);
            if (d0 == 0) { const v4u pw = *(const v4u*)(qp + (1 - h) * 8); float o8[8]; rope8(w, pw, F.ROPE + qpos * 16, h, o8); w = pack8(o8); }
            qr[d0] = __builtin_bit_cast(bf16x8, w); }
        f32x16 acc[5];
#pragma unroll
        for (int t = 0; t < 5; ++t) {
#pragma unroll
            for (int r = 0; r < 16; ++r) acc[t][r] = 0.f;
#pragma unroll
            for (int d0 = 0; d0 < 4; ++d0) { const bf16x8 kfrag = *(const LAS bf16x8*)(KL + (32 * (qs + t) + q) * AT_KROW + (2 * d0 + h) * 16);
                acc[t] = __builtin_amdgcn_mfma_f32_32x32x16_bf16(kfrag, qr[d0], acc[t], 0, 0, 0); } }
        float mx = -1e30f;
#pragma unroll
        for (int t = 0; t < 5; ++t)
#pragma unroll
            for (int r = 0; r < 16; ++r) { const int j = 32 * (qs + t) + crow(r, h), i = i0 + q;
                const bool valid = (j > i) && (j <= i + 128) && (qb > 0 || j >= 128);
                const float s = valid ? acc[t][r] * SC : -1e30f; acc[t][r] = s; mx = __builtin_fmaxf(mx, s); }
        mx = __builtin_fmaxf(mx, __shfl_xor(mx, 32)); mx = __builtin_fmaxf(mx, sinkl);
        float sum = 0.f;
#pragma unroll
        for (int t = 0; t < 5; ++t)
#pragma unroll
            for (int r = 0; r < 16; ++r) { const float pp = __builtin_amdgcn_exp2f(acc[t][r] - mx); acc[t][r] = pp; sum += pp; }
        sum += __shfl_xor(sum, 32);
        const float inv = 1.f / (sum + __builtin_amdgcn_exp2f(sinkl - mx));
        if (h == 0) WSF[q] = inv;
        f32x16 o[2];
#pragma unroll
        for (int r = 0; r < 16; ++r) { o[0][r] = 0.f; o[1][r] = 0.f; }
#pragma unroll
        for (int t = 0; t < 5; ++t)
#pragma unroll
            for (int s = 0; s < 2; ++s) {
                v4u pw; pw.x = pk2(acc[t][8 * s + 0], acc[t][8 * s + 1]); pw.y = pk2(acc[t][8 * s + 2], acc[t][8 * s + 3]); pw.z = pk2(acc[t][8 * s + 4], acc[t][8 * s + 5]); pw.w = pk2(acc[t][8 * s + 6], acc[t][8 * s + 7]);
                const bf16x8 pfrag = __builtin_bit_cast(bf16x8, pw);
#pragma unroll
                for (int dh = 0; dh < 2; ++dh) { const LAS unsigned char* vp = VT + (32 * dh + q) * AT_VROW + (32 * (qs + t) + 16 * s + 4 * h) * 2;
                    const v2u lo = *(const LAS v2u*)vp, hi = *(const LAS v2u*)(vp + 16);
                    const v4u vw = (v4u){lo.x, lo.y, hi.x, hi.y};
                    o[dh] = __builtin_amdgcn_mfma_f32_32x32x16_bf16(pfrag, __builtin_bit_cast(bf16x8, vw), o[dh], 0, 0, 0); } }
        LDS_WAIT();
        bf16* op = F.MIX + ((size_t)b * SEQ + qb * 128 + i0) * DM + head * 64 + q;
#pragma unroll
        for (int r = 0; r < 16; ++r) { const float rl = WSF[crow(r, h)];
            op[(size_t)crow(r, h) * DM] = (bf16)f2bf(o[0][r] * rl); op[(size_t)crow(r, h) * DM + 32] = (bf16)f2bf(o[1][r] * rl); }
        LDS_WAIT();
    }
    __syncthreads();
}
constexpr int AS_K = 0, AS_V = 34320, AS_Q = 68640, AS_P = 72736;
__device__ __forceinline__ void attn_sample_unit(Frame& F, int b, int kvh) {
    LAS float* Ks = (LAS float*)(F.lds + AS_K); LAS float* Vs = (LAS float*)(F.lds + AS_V); LAS float* Qs = (LAS float*)(F.lds + AS_Q); LAS float* Ps = (LAS float*)(F.lds + AS_P);
    for (int idx = F.tid; idx < 132 * 64; idx += 512) {
        const int j = idx >> 6, d = idx & 63; float kval, vval;
        if (j < 128) { kval = F.cache_k[((size_t)(b * 128 + j) * 2 + kvh) * 64 + d]; vval = F.cache_v[((size_t)(b * 128 + j) * 2 + kvh) * 64 + d]; }
        else { const int t = j - 128; const bf16* rowp = F.QKVU + (size_t)(MP + b * DS + t) * INW;
            kval = bf1(rowp[COL_K + kvh * 64 + d]); vval = bf1(rowp[COL_V + kvh * 64 + d]);
            if (d < 16) { const float* tab = F.ROPE + (SEQ + t) * 16; const float other = bf1(rowp[COL_K + kvh * 64 + (d ^ 8)]);
                kval = (d < 8) ? kval * tab[d] - other * tab[8 + d] : kval * tab[d - 8] + other * tab[8 + d - 8]; } }
        Ks[j * 65 + d] = kval; Vs[j * 65 + d] = vval;
        if (j >= DS) { F.out[O_KWS + ((size_t)(b * 128 + (j - DS)) * 2 + kvh) * 64 + d] = kval; F.out[O_VWS + ((size_t)(b * 128 + (j - DS)) * 2 + kvh) * 64 + d] = vval; }
    }
    for (int idx = F.tid; idx < 16 * 64; idx += 512) {
        const int r = idx >> 6, d = idx & 63, t = r >> 2, head = kvh * 4 + (r & 3);
        const bf16* rowp = F.QKVU + (size_t)(MP + b * DS + t) * INW + head * 64;
        float qv = bf1(rowp[d]);
        if (d < 16) { const float* tab = F.ROPE + (SEQ + t) * 16; const float other = bf1(rowp[d ^ 8]);
            qv = (d < 8) ? qv * tab[d] - other * tab[8 + d] : qv * tab[d - 8] + other * tab[8 + d - 8]; }
        Qs[r * 64 + d] = qv;
    }
    __syncthreads();
    const int r = F.tid >> 5, ln = F.tid & 31, t = r >> 2, head = kvh * 4 + (r & 3);
    {
        float s[5]; float mx = -1e30f;
#pragma unroll
        for (int k = 0; k < 5; ++k) { const int j = ln + 32 * k; float a = -1e30f;
            if (j < 132) { float d_ = 0.f;
#pragma unroll 8
                for (int d = 0; d < 64; ++d) d_ += Qs[r * 64 + d] * Ks[j * 65 + d];
                const bool valid = (j > t) && (j <= t + 128); a = valid ? d_ * 0.125f : -1e30f; }
            s[k] = a; mx = __builtin_fmaxf(mx, a); }
#pragma unroll
        for (int o = 16; o >= 1; o >>= 1) mx = __builtin_fmaxf(mx, __shfl_xor(mx, o));
        const float sk = F.sinks[head]; mx = __builtin_fmaxf(mx, sk);
        float sum = 0.f;
#pragma unroll
        for (int k = 0; k < 5; ++k) { s[k] = __expf(s[k] - mx); sum += s[k]; }
#pragma unroll
        for (int o = 16; o >= 1; o >>= 1) sum += __shfl_xor(sum, o);
        const float inv = 1.f / (sum + __expf(sk - mx));
#pragma unroll
        for (int k = 0; k < 5; ++k) { const int j = ln + 32 * k; if (j < 132) Ps[r * 136 + j] = s[k] * inv; }
    }
    __syncthreads();
    {
        float o0 = 0.f, o1 = 0.f;
#pragma unroll 4
        for (int j = 0; j < 132; ++j) { const float pj = Ps[r * 136 + j]; o0 += pj * Vs[j * 65 + ln]; o1 += pj * Vs[j * 65 + ln + 32]; }
        bf16* op = F.MIX + (size_t)(MP + b * DS + t) * DM + head * 64;
        op[ln] = (bf16)f2bf(o0); op[ln + 32] = (bf16)f2bf(o1);
    }
    __syncthreads();
}
__device__ __forceinline__ void attn_phase(Frame& F) {
    for (int id = F.vcu; id < NB * 16 * 2; id += F.G) { const int kvh = id & 1, qb = (id >> 1) & 15, b = id >> 5; attn_prompt_unit(F, b, qb, kvh); }
    for (int id = F.vcu; id < DB * 2; id += F.G) attn_sample_unit(F, id >> 1, id & 1);
}

constexpr int SS_U = 0, SS_UCH = 528;
constexpr int SS_DX = 33792, SS_DXS = 129;
constexpr int SS_XIN = SS_DX + 64 * 129 * 4, SS_XCH = 272;
constexpr int SS_E = SS_XIN + 64 * 272;
constexpr int SS_XS = SS_E + 4096;
static_assert(SS_XS + 1024 <= RING_BYTES, "ssm lds");
__device__ __forceinline__ void sincos_d(double ang, double& c, double& s) {
    const double k = __builtin_rint(ang * 0.15915494309189535);
    double r = __builtin_fma(-k, 6.283185307179586, ang); r = __builtin_fma(-k, 2.4492935982947064e-16, r);
    const double r2 = r * r; double ts = r, ss = r, tc = 1.0, cc = 1.0;
#pragma unroll
    for (int n = 1; n <= 13; ++n) { ts *= -r2 / (double)((2 * n) * (2 * n + 1)); ss += ts; tc *= -r2 / (double)((2 * n - 1) * (2 * n)); cc += tc; }
    c = cc; s = ss;
}
__device__ __forceinline__ void p0_ssm_tables(Frame& F, int g) {
    LAS float* L = (LAS float*)F.lds;
    LAS float *PWR = L, *PWI = L + 1088, *BBR = L + 2176, *BBI = L + 3200, *CR = L + 4224, *CI = L + 5248, *KD = L + 6272;
    if (F.tid < 64) {
        const int p = F.tid;
        const float dt = expf(F.log_dt[g]); const float ar = F.a_re[g * NP + p], ai = F.a_im[g * NP + p];
        const double angd = (double)ai * (double)dt;
        for (int d = 0; d <= 16; ++d) { const float mag = expf((float)d * ar * dt); double c, s; sincos_d((double)d * angd, c, s); PWR[d * 64 + p] = mag * (float)c; PWI[d * 64 + p] = mag * (float)s; }
        { const float mag = expf(128.f * ar * dt); double c, s; sincos_d(128.0 * angd, c, s);
          F.SAT[(g * NP + p) * 4 + 0] = PWR[16 * 64 + p]; F.SAT[(g * NP + p) * 4 + 1] = PWI[16 * 64 + p]; F.SAT[(g * NP + p) * 4 + 2] = mag * (float)c; F.SAT[(g * NP + p) * 4 + 3] = mag * (float)s; }
        double c1, s1; sincos_d(angd, c1, s1); const double mag1 = (double)expf(ar * dt);
        const float nr = (float)(mag1 * c1 - 1.0), ni = (float)(mag1 * s1);
        const float den = ar * ar + ai * ai;
        const float fre = (nr * ar + ni * ai) / den, fim = (ni * ar - nr * ai) / den;
        for (int c = 0; c < 16; ++c) { const float br = F.b_re[(g * NP + p) * GC + c], bi = F.b_im[(g * NP + p) * GC + c];
            BBR[p * 16 + c] = fre * br - fim * bi; BBI[p * 16 + c] = fre * bi + fim * br; }
    }
    for (int e = F.tid; e < 1024; e += NWAVES * 64) { CR[e] = F.c_re[g * 1024 + e]; CI[e] = F.c_im[g * 1024 + e]; }
    __syncthreads();
    for (int e = F.tid; e < 4096; e += NWAVES * 64) { const int d = e >> 8, co = (e >> 4) & 15, ci = e & 15; float sum = 0.f;
        for (int p = 0; p < 64; ++p) { const float pr = PWR[d * 64 + p], pi = PWI[d * 64 + p], br = BBR[p * 16 + ci], bi = BBI[p * 16 + ci];
            const float qr = pr * br - pi * bi, qi = pr * bi + pi * br; sum += CR[co * 64 + p] * qr - CI[co * 64 + p] * qi; }
        if (d == 0 && co == ci) sum += F.d_skip[g * GC + co];
        KD[e] = sum; }
    __syncthreads();
    for (int e = F.tid; e < 16 * 64; e += NWAVES * 64) { const int fi = e >> 6, lane = e & 63, R = lane & 31, h = lane >> 5, d = fi - 1 + (R >> 4); float v[8];
#pragma unroll
        for (int j = 0; j < 8; ++j) v[j] = (d >= 0 && d < 16) ? KD[d * 256 + (R & 15) * 16 + 8 * h + j] : 0.f;
        *(v4u*)(F.SFT + ((size_t)(g * 16 + fi) * 64 + lane) * 8) = pack8(v); }
    for (int e = F.tid; e < 4 * 16 * 64; e += NWAVES * 64) { const int lane = e & 63, j = (e >> 6) & 15, mt = e >> 10, R = lane & 31, h = lane >> 5, pp = 32 * mt + R, p = pp & 63; float v[8];
#pragma unroll
        for (int jj = 0; jj < 8; ++jj) { const int ci = 8 * h + jj; const float pr = PWR[(15 - j) * 64 + p], pi = PWI[(15 - j) * 64 + p], br = BBR[p * 16 + ci], bi = BBI[p * 16 + ci];
            v[jj] = pp < 64 ? pr * br - pi * bi : pr * bi + pi * br; }
        *(v4u*)(F.SSF + ((size_t)((g * 4 + mt) * 16 + j) * 64 + lane) * 8) = pack8(v); }
    for (int e = F.tid; e < 8 * 8 * 64; e += NWAVES * 64) { const int lane = e & 63, kk = (e >> 6) & 7, mt = e >> 9, R = lane & 31, h = lane >> 5, l = 2 * mt + (R >> 4), co = R & 15; float v[8];
#pragma unroll
        for (int jj = 0; jj < 8; ++jj) { const int pp = 16 * kk + 8 * h + jj, p = pp & 63; const float cr = CR[co * 64 + p], ci = CI[co * 64 + p], pr = PWR[(l + 1) * 64 + p], pi = PWI[(l + 1) * 64 + p];
            v[jj] = pp < 64 ? cr * pr - ci * pi : -(cr * pi + ci * pr); }
        *(v4u*)(F.SCF + ((size_t)((g * 8 + mt) * 8 + kk) * 64 + lane) * 8) = pack8(v); }
    __syncthreads();
}
__device__ __forceinline__ void ssm_segment(Frame& F, int b, int g, int seg, int par, bool last) {
    LAS unsigned char* U = F.lds + SS_U; LAS float* DX = (LAS float*)(F.lds + SS_DX); LAS unsigned char* XIN = F.lds + SS_XIN;
    LAS float* E = (LAS float*)(F.lds + SS_E); LAS float* XS = (LAS float*)(F.lds + SS_XS);
    const int lane = F.lane, w = F.wave, n = lane & 31, h = lane >> 5;
    const size_t r0 = (size_t)b * SEQ + (size_t)seg * 1024;
#pragma unroll
    for (int it = 0; it < 4; ++it) { const int idx = F.tid + it * 512, tok = idx >> 1, half = idx & 1;
        const v4u v = *(const v4u*)(F.QKVU + (r0 + tok) * INW + COL_U + GC * g + 8 * half);
        *(LAS v4u*)(U + (tok >> 4) * SS_UCH + (tok & 15) * 32 + 16 * half) = v; }
    __syncthreads();
    {
        const int mt = w & 3, nt = w >> 2;
        const bf16* sf = F.SSF + ((size_t)(g * 4 + mt) * 16 * 64 + lane) * 8;
        f32x16 acc;
#pragma unroll
        for (int r = 0; r < 16; ++r) acc[r] = 0.f;
#pragma unroll
        for (int j = 0; j < 16; ++j) { const bf16x8 a = *(const bf16x8*)(sf + (size_t)j * 64 * 8);
            const bf16x8 bb = *(const LAS bf16x8*)(U + (32 * nt + n) * SS_UCH + j * 32 + 16 * h);
            acc = __builtin_amdgcn_mfma_f32_32x32x16_bf16(a, bb, acc, 0, 0, 0); }
#pragma unroll
        for (int r = 0; r < 16; ++r) DX[(32 * nt + n) * SS_DXS + 32 * mt + crow(r, h)] = acc[r];
    }
    __syncthreads();
    {
        const int p = lane;
        const f32x4 at = *(const f32x4*)(F.SAT + (g * NP + p) * 4);
        float lr[8], li[8]; float sr = 0.f, si = 0.f;
#pragma unroll
        for (int i = 0; i < 8; ++i) { const int c = 8 * w + i; lr[i] = sr; li[i] = si; const float dr = DX[c * SS_DXS + p], di = DX[c * SS_DXS + 64 + p];
            const float nr = at.x * sr - at.y * si + dr, ni = at.x * si + at.y * sr + di; sr = nr; si = ni; }
        E[(w * 2 + 0) * 64 + p] = sr; E[(w * 2 + 1) * 64 + p] = si;
        __syncthreads();
        float cr = XS[(par * 2 + 0) * 64 + p], ci = XS[(par * 2 + 1) * 64 + p], myr = 0.f, myi = 0.f;
#pragma unroll
        for (int v = 0; v < 8; ++v) { if (v == w) { myr = cr; myi = ci; } const float er = E[(v * 2 + 0) * 64 + p], ei = E[(v * 2 + 1) * 64 + p];
            const float nr = at.z * cr - at.w * ci + er, ni = at.z * ci + at.w * cr + ei; cr = nr; ci = ni; }
        if (w == 0) { XS[((par ^ 1) * 2 + 0) * 64 + p] = cr; XS[((par ^ 1) * 2 + 1) * 64 + p] = ci;
            if (last) { F.out[O_SRP + (size_t)(b * NG + g) * NP + p] = cr; F.out[O_SIP + (size_t)(b * NG + g) * NP + p] = ci; } }
        float pr = 1.f, pi = 0.f;
#pragma unroll
        for (int i = 0; i < 8; ++i) { const int c = 8 * w + i; const float xr = lr[i] + pr * myr - pi * myi, xi = li[i] + pr * myi + pi * myr;
            *(LAS bf16*)(XIN + c * SS_XCH + 2 * p) = (bf16)f2bf(xr); *(LAS bf16*)(XIN + c * SS_XCH + 128 + 2 * p) = (bf16)f2bf(xi);
            const float npr = pr * at.x - pi * at.y, npi = pr * at.y + pi * at.x; pr = npr; pi = npi; }
    }
    __syncthreads();
    {
        const bf16* ft = F.SFT + ((size_t)g * 16 * 64 + lane) * 8;
        const bf16* cf = F.SCF + ((size_t)(g * 8 + w) * 8 * 64 + lane) * 8;
        f32x16 acc[2];
#pragma unroll
        for (int r = 0; r < 16; ++r) { acc[0][r] = 0.f; acc[1][r] = 0.f; }
#pragma unroll
        for (int j = 0; j < 16; ++j) { if (j <= 2 * w + 1) { const bf16x8 a = *(const bf16x8*)(ft + (size_t)(2 * w - j + 1) * 64 * 8);
#pragma unroll
            for (int nt = 0; nt < 2; ++nt) { const bf16x8 bb = *(const LAS bf16x8*)(U + (32 * nt + n) * SS_UCH + j * 32 + 16 * h);
                acc[nt] = __builtin_amdgcn_mfma_f32_32x32x16_bf16(a, bb, acc[nt], 0, 0, 0); } } }
#pragma unroll
        for (int kk = 0; kk < 8; ++kk) { const bf16x8 a = *(const bf16x8*)(cf + (size_t)kk * 64 * 8);
#pragma unroll
            for (int nt = 0; nt < 2; ++nt) { const bf16x8 bb = *(const LAS bf16x8*)(XIN + (32 * nt + n) * SS_XCH + kk * 32 + 16 * h);
                acc[nt] = __builtin_amdgcn_mfma_f32_32x32x16_bf16(a, bb, acc[nt], 0, 0, 0); } }
#pragma unroll
        for (int nt = 0; nt < 2; ++nt)
#pragma unroll
            for (int rq = 0; rq < 4; ++rq) { const int tok = 16 * (32 * nt + n) + 2 * w + (rq >> 1), co0 = 8 * (rq & 1) + 4 * h;
                v2u o; o.x = pk2(gelu_tanh(acc[nt][4 * rq + 0]), gelu_tanh(acc[nt][4 * rq + 1])); o.y = pk2(gelu_tanh(acc[nt][4 * rq + 2]), gelu_tanh(acc[nt][4 * rq + 3]));
                *(v2u*)(F.GB + (r0 + tok) * SSMW + GC * g + co0) = o; }
    }
    __syncthreads();
}
__device__ __forceinline__ void ssm_phase(Frame& F) {
    for (int id = F.vcu; id < NG * (NB / 2); id += F.G) { const int g = id >> 3, b0 = 2 * (id & 7);
        for (int bi = 0; bi < 2; ++bi) {
            if (F.tid < 128) ((LAS float*)(F.lds + SS_XS))[F.tid] = 0.f;
            ssm_segment(F, b0 + bi, g, 0, 0, false);
            ssm_segment(F, b0 + bi, g, 1, 1, true);
        } }
    for (int id = F.vcu * NWAVES + F.wave; id < DB * NG; id += F.G * NWAVES) { const int b = id / NG, g = id % NG;
        ssm_unit_naive(F, MP + b * DS, DS, g, true, (b * NG + g) * NP, F.out + O_SRS, F.out + O_SIS); }
}

__device__ __forceinline__ void rowpass1(Frame& F) {
    const int gw = F.vcu * NWAVES + F.wave, NGW = F.G * NWAVES;
    for (int m = gw; m < M; m += NGW) {
        const f32x4* xr = (const f32x4*)xrow_ptr(F, m) + F.lane; const v2u* mr = (const v2u*)(F.MIXO + (size_t)m * DM) + F.lane;
        f32x4 xv[4], mv[4]; float s = 0.f;
#pragma unroll
        for (int j = 0; j < 4; ++j) { xv[j] = xr[64 * j]; const v2u w = mr[64 * j]; mv[j] = (f32x4){bflo(w.x), bfhi(w.x), bflo(w.y), bfhi(w.y)};
            s += (mv[j].x * mv[j].x + mv[j].y * mv[j].y) + (mv[j].z * mv[j].z + mv[j].w * mv[j].w); }
        const float rinv = 1.f / sqrtf(wave_sum(s) * (1.f / DM) + NORM_EPS);
        float s2 = 0.f; f32x4* orow = (f32x4*)(F.out + (size_t)m * DM) + F.lane;
#pragma unroll
        for (int j = 0; j < 4; ++j) { const f32x4 g = ((const f32x4*)F.g_mix_post + F.lane)[64 * j]; xv[j] = xv[j] + mv[j] * rinv * g; orow[64 * j] = xv[j];
            s2 += (xv[j].x * xv[j].x + xv[j].y * xv[j].y) + (xv[j].z * xv[j].z + xv[j].w * xv[j].w); }
        const float rinv2 = 1.f / sqrtf(wave_sum(s2) * (1.f / DM) + NORM_EPS);
        unsigned long long* o8 = (unsigned long long*)(F.XN + (size_t)m * DM) + F.lane;
#pragma unroll
        for (int j = 0; j < 4; ++j) { const f32x4 g = ((const f32x4*)F.g_mlp_pre + F.lane)[64 * j]; const f32x4 y = xv[j] * rinv2 * g;
            o8[64 * j] = (unsigned long long)pk2(y.x, y.y) | ((unsigned long long)pk2(y.z, y.w) << 32); }
    }
}
__device__ __forceinline__ void rowpass2(Frame& F) {
    const int gw = F.vcu * NWAVES + F.wave, NGW = F.G * NWAVES;
    for (int m = gw; m < M; m += NGW) {
        f32x4* orow = (f32x4*)(F.out + (size_t)m * DM) + F.lane; const v2u* mr = (const v2u*)(F.XN + (size_t)m * DM) + F.lane;
        f32x4 xv[4], mv[4]; float s = 0.f;
#pragma unroll
        for (int j = 0; j < 4; ++j) { xv[j] = orow[64 * j]; const v2u w = mr[64 * j]; mv[j] = (f32x4){bflo(w.x), bfhi(w.x), bflo(w.y), bfhi(w.y)};
            s += (mv[j].x * mv[j].x + mv[j].y * mv[j].y) + (mv[j].z * mv[j].z + mv[j].w * mv[j].w); }
        const float rinv = 1.f / sqrtf(wave_sum(s) * (1.f / DM) + NORM_EPS);
#pragma unroll
        for (int j = 0; j < 4; ++j) { const f32x4 g = ((const f32x4*)F.g_mlp_post + F.lane)[64 * j]; orow[64 * j] = xv[j] + mv[j] * rinv * g; }
    }
}

struct Args { const float* in[25]; float* out; unsigned char* ws; int ph_lo, ph_hi; };
__global__ void __launch_bounds__(NWAVES * 64, 2) mega_fwd(Args args) {
    extern __shared__ __attribute__((aligned(16))) unsigned char lds[];
    Frame F;
    F.lds = (LAS unsigned char*)lds;
    F.MISC = (volatile LAS unsigned*)(F.lds + MISC_OFF);
    F.tid = threadIdx.x; F.lane = F.tid & 63; F.wave = __builtin_amdgcn_readfirstlane(F.tid >> 6);
    F.G = gridDim.x; { const int bx = blockIdx.x; F.vcu = (F.G % 8 == 0) ? (bx % 8) * (F.G / 8) + bx / 8 : bx; }
    unsigned char* ws = args.ws;
    F.ctl = (gu32*)(ws + WS_CTL);
    F.x_prompt = args.in[0]; F.x_sample = args.in[1]; F.cache_k = args.in[2]; F.cache_v = args.in[3]; F.s0_re = args.in[4]; F.s0_im = args.in[5]; F.g_mix_pre = args.in[6];
    F.w_in = args.in[7]; F.sinks = args.in[8]; F.a_re = args.in[9]; F.a_im = args.in[10]; F.log_dt = args.in[11]; F.b_re = args.in[12]; F.b_im = args.in[13];
    F.c_re = args.in[14]; F.c_im = args.in[15]; F.d_skip = args.in[16]; F.w_glu = args.in[17]; F.b_glu = args.in[18]; F.w_out = args.in[19]; F.g_mix_post = args.in[20];
    F.g_mlp_pre = args.in[21]; F.w_up = args.in[22]; F.w_down = args.in[23]; F.g_mlp_post = args.in[24]; F.out = args.out;
    F.Win_t = (bf16*)(ws + WS_WIN); F.Wglu_t = (bf16*)(ws + WS_WGLU); F.Wout_t = (bf16*)(ws + WS_WOUT); F.Wup_t = (bf16*)(ws + WS_WUP); F.Wdn_t = (bf16*)(ws + WS_WDN);
    F.ROPE = (float*)(ws + WS_ROPE); F.SFT = (bf16*)(ws + WS_SSM_FT); F.SSF = (bf16*)(ws + WS_SSM_SF); F.SCF = (bf16*)(ws + WS_SSM_CF); F.SAT = (float*)(ws + WS_SSM_AT);
    F.QKVU = (bf16*)(ws + WS_QKVU); F.MIX = (bf16*)(ws + WS_MIX); F.GB = (bf16*)(ws + WS_G); F.MIXO = (bf16*)(ws + WS_MIXO); F.HB = (bf16*)(ws + WS_H); F.XN = (bf16*)(ws + WS_XN);
    for (int u = F.tid; u < (LDS_BYTES - LDSCTL_OFF) / 4; u += NWAVES * 64) ((LAS unsigned*)(F.lds + LDSCTL_OFF))[u] = 0u;
    __syncthreads();
    const int lo = args.ph_lo, hi = args.ph_hi;
    const bool use_bar = (hi - lo) > 1;
    XcdBarrier bar; bar.bar = (unsigned*)(F.ctl + CW_BAR); bar.x = 0; bar.st = nullptr;
    if (use_bar) bar = xcd_barrier_post((unsigned*)(F.ctl + CW_BAR), F.MISC + 8);
#ifndef PHASE_MASK
#define PHASE_MASK 0x1ff
#endif
#define IN(k) (((PHASE_MASK >> (k)) & 1) && lo <= (k) && (k) < hi)
#define SEAM(k) do { if (IN(k) && IN((k) + 1)) xcd_barrier(bar); } while (0)

    if (IN(0)) { for (int g = F.vcu; g < NG; g += F.G) p0_ssm_tables(F, g); p0_prologue(F); SEAM(0); }
    if (IN(1)) {
        pg8::Gemm g{F.XN, F.Win_t, M, INW, DM}; pg8::StaticOrder S; S.init(M, INW, F.G, (int)blockIdx.x);
        pg8::EpiStore<0> E{F.QKVU, INW};
        pg8::gemm_phase<pg8::EpiStore<0>, pg8::StaticOrder, PG8_ALIGN, PG8_SP2>(F.lds + RING_OFF, g, S, E);
        SEAM(1);
    }
    if (IN(2)) { ssm_phase(F); __syncthreads(); attn_phase(F); SEAM(2); }
    if (IN(3)) {
        pg8::Gemm g{F.GB, F.Wglu_t, M, SSMW, SSMW}; pg8::StaticOrder S; S.init(M, SSMW, F.G, (int)blockIdx.x);
        pg8::EpiGlu E{F.GB, F.b_glu, F.MIX};
        pg8::gemm_phase<pg8::EpiGlu, pg8::StaticOrder, PG8_ALIGN, PG8_SP2>(F.lds + RING_OFF, g, S, E);
        SEAM(3);
    }
    if (IN(4)) {
        pg8::Gemm g{F.MIX, F.Wout_t, M, DM, DM}; pg8::StaticOrder S; S.init(M, DM, F.G, (int)blockIdx.x);
        pg8::EpiStore<0> E{F.MIXO, DM};
        pg8::gemm_phase<pg8::EpiStore<0>, pg8::StaticOrder, PG8_ALIGN, PG8_SP2>(F.lds + RING_OFF, g, S, E);
        SEAM(4);
    }
    if (IN(5)) { rowpass1(F); SEAM(5); }
    if (IN(6)) {
        pg8::Gemm g{F.XN, F.Wup_t, M, FF, DM}; pg8::StaticOrder S; S.init(M, FF, F.G, (int)blockIdx.x);
        pg8::EpiStore<2> E{F.HB, FF};
        pg8::gemm_phase<pg8::EpiStore<2>, pg8::StaticOrder, PG8_ALIGN, PG8_SP2>(F.lds + RING_OFF, g, S, E);
        SEAM(6);
    }
    if (IN(7)) {
        pg8::Gemm g{F.HB, F.Wdn_t, M, DM, FF}; pg8::StaticOrder S; S.init(M, DM, F.G, (int)blockIdx.x);
        pg8::EpiStore<0> E{F.XN, DM};
        pg8::gemm_phase<pg8::EpiStore<0>, pg8::StaticOrder, PG8_ALIGN, PG8_SP2>(F.lds + RING_OFF, g, S, E);
        SEAM(7);
    }
    if (IN(8)) { rowpass2(F); }
#undef IN
#undef SEAM
}

extern "C" void kernel_launch(void* const* d_in, const int* in_sizes, int n_in, void* d_out, int out_size, void* d_ws, size_t ws_size, hipStream_t stream) {
    static int grid = 0;
    if (grid == 0) {
        if (n_in != 25 || out_size != (int)O_END || ws_size < WS_END) { fprintf(stderr, "kernel_launch: unexpected shapes n_in %d out %d ws %zu\n", n_in, out_size, ws_size); grid = -1; return; }
        int dev = 0, cus = 0, per_cu = 0;
        if (hipGetDevice(&dev) != hipSuccess || hipDeviceGetAttribute(&cus, hipDeviceAttributeMultiprocessorCount, dev) != hipSuccess) { grid = -1; return; }
        if (hipFuncSetAttribute((const void*)mega_fwd, hipFuncAttributeMaxDynamicSharedMemorySize, LDS_BYTES) != hipSuccess) { fprintf(stderr, "kernel_launch: hipFuncSetAttribute failed\n"); grid = -1; return; }
        if (hipOccupancyMaxActiveBlocksPerMultiprocessor(&per_cu, (const void*)mega_fwd, NWAVES * 64, LDS_BYTES) != hipSuccess || per_cu < 1)
            fprintf(stderr, "kernel_launch: note: occupancy query reports %d workgroups per CU\n", per_cu);
        (void)hipGetLastError();
        grid = cus;
    }
    if (grid < 0) return;
    if (hipMemsetAsync((char*)d_ws + WS_CTL, 0, CTL_ZERO_BYTES, stream) != hipSuccess) { fprintf(stderr, "kernel_launch: memset failed\n"); return; }
    Args a{};
    for (int i = 0; i < 25; ++i) a.in[i] = (const float*)d_in[i];
    a.out = (float*)d_out; a.ws = (unsigned char*)d_ws;
    if (N_LAUNCHES == 1) { a.ph_lo = 0; a.ph_hi = N_PHASES; hipLaunchKernelGGL(mega_fwd, dim3(grid), dim3(NWAVES * 64), LDS_BYTES, stream, a); }
    else { for (int li = 0; li < N_PHASES; ++li) { a.ph_lo = li; a.ph_hi = li + 1; hipLaunchKernelGGL(mega_fwd, dim3(grid), dim3(NWAVES * 64), LDS_BYTES, stream, a); } }
    const hipError_t le = hipPeekAtLastError();
    if (le != hipSuccess) fprintf(stderr, "kernel_launch: launch failed: %s\n", hipGetErrorName(le));
}
```
